# Optimizing an MI355X kernel written in HIP

```python
import math
import jax, jax.numpy as jnp
from jax import lax
import numpy as np

D_MODEL = 1024
BATCH = 8
SEQ = 2048
DEPTH = 1

GRID_W = 64
CTX_LEN = 256
HEAD_DIM = 64
N_HEADS = 16
N_KV_HEADS = 4
GROUP = N_HEADS // N_KV_HEADS
ROPE_AXIS_DIM = HEAD_DIM // 2
ROPE_THETA = 10000.0
Q_BLOCK = 128
N_FGROUPS = 4
FGROUP_DIM = 128
N_BRANCH = 2
Q_W = N_HEADS * HEAD_DIM
KV_W = N_KV_HEADS * HEAD_DIM
F_W = N_FGROUPS * FGROUP_DIM
K_END = Q_W + KV_W
V_END = K_END + KV_W
F_END = V_END + F_W
IN_W = F_END + N_BRANCH * D_MODEL
D_FF = ((8 * D_MODEL // 3 + 255) // 256) * 256
EPS = 1e-6

kernel_name = 'hybrid_gqa_fnet_dit_layer'


def rms_norm(x, gain):
    xf = x.astype(jnp.float32)
    y = xf * lax.rsqrt(jnp.mean(xf * xf, axis=-1, keepdims=True) + EPS)
    return (y * gain.astype(jnp.float32)).astype(x.dtype)


def modulate(h, shift, scale):
    return h * (1 + scale) + shift


def adaln(cond, w_ada, b_ada):
    m = jax.nn.silu(cond) @ w_ada + b_ada
    return jnp.split(m, 6, axis=-1)


def axial_rope_tables(rows, dtype):
    t_row = jnp.repeat(jnp.arange(rows, dtype=jnp.float32), GRID_W)
    t_col = jnp.tile(jnp.arange(GRID_W, dtype=jnp.float32), rows)
    inv_freq = ROPE_THETA ** (-jnp.arange(0, ROPE_AXIS_DIM, 2, dtype=jnp.float32) / ROPE_AXIS_DIM)
    ang = jnp.concatenate([t_row[:, None] * inv_freq, t_col[:, None] * inv_freq], axis=-1)
    return jnp.cos(ang)[:, None, :].astype(dtype), jnp.sin(ang)[:, None, :].astype(dtype)


def apply_rope(x, cos, sin):
    x1, x2 = jnp.split(x, 2, axis=-1)
    return jnp.concatenate([x1 * cos - x2 * sin, x2 * cos + x1 * sin], axis=-1)


def split_in_proj(z):
    return jnp.split(z, [Q_W, K_END, V_END, F_END], axis=-1)


def to_heads(t, n):
    return t.reshape(t.shape[0], t.shape[1], n, HEAD_DIM)


def blocked_attention(q, k, v):
    B, L = q.shape[0], q.shape[1]
    nb = L // Q_BLOCK
    qb = q.reshape(B, nb, Q_BLOCK, N_KV_HEADS, GROUP, HEAD_DIM).transpose(1, 0, 2, 3, 4, 5)
    scale = HEAD_DIM ** -0.5

    def one_block(q_blk):
        s = jnp.einsum('bqkgd,btkd->bkgqt', q_blk, k).astype(jnp.float32) * scale
        p = jax.nn.softmax(s, axis=-1).astype(v.dtype)
        return jnp.einsum('bkgqt,btkd->bqkgd', p, v)

    o = lax.map(one_block, qb)
    return o.transpose(1, 0, 2, 3, 4, 5).reshape(B, L, Q_W)


def fourier_mix(f):
    B, L = f.shape[0], f.shape[1]
    fg = f.reshape(B, L, N_FGROUPS, FGROUP_DIM).astype(jnp.float32)
    y = jnp.real(jnp.fft.fft2(fg, axes=(1, 3), norm='ortho'))
    return y.reshape(B, L, F_W).astype(f.dtype)


def merge_branches(attn, four, gate_logits, b_gate, w_attn_proj, w_fourier_proj, w_o):
    g_attn, g_four = jnp.split(jax.nn.sigmoid(gate_logits + b_gate), N_BRANCH, axis=-1)
    merged = g_attn * (attn @ w_attn_proj) + g_four * (fourier_mix(four) @ w_fourier_proj)
    return merged @ w_o


def swiglu(h, w_gate_up, w_down):
    gate, up = jnp.split(h @ w_gate_up, 2, axis=-1)
    return (jax.nn.silu(gate) * up) @ w_down


def setup_inputs(seed: int = 0) -> dict:
    key = jax.random.key(seed)
    ks = jax.random.split(key, 18)

    def nrm(k, shape, scale):
        return jax.random.normal(k, shape, jnp.float32) * scale

    return {
        'x': nrm(ks[0], (BATCH, SEQ, D_MODEL), 1.0),
        'c': nrm(ks[1], (BATCH, D_MODEL), 1.0),
        'ctx': nrm(ks[2], (BATCH, CTX_LEN, D_MODEL), 1.0),
        'c_ctx': nrm(ks[3], (D_MODEL,), 1.0),
        'w_ada': nrm(ks[4], (DEPTH, D_MODEL, 6 * D_MODEL), 0.5 * D_MODEL ** -0.5),
        'b_ada': nrm(ks[5], (DEPTH, 6 * D_MODEL), 0.01),
        'g_norm_mix': 1.0 + nrm(ks[6], (DEPTH, D_MODEL), 0.1),
        'g_norm_ffn': 1.0 + nrm(ks[7], (DEPTH, D_MODEL), 0.1),
        'w_in': nrm(ks[8], (DEPTH, D_MODEL, IN_W), D_MODEL ** -0.5),
        'b_gate': nrm(ks[9], (DEPTH, N_BRANCH * D_MODEL), 0.1),
        'g_q': 1.0 + nrm(ks[10], (DEPTH, HEAD_DIM), 0.1),
        'g_k': 1.0 + nrm(ks[11], (DEPTH, HEAD_DIM), 0.1),
        'w_attn_proj': nrm(ks[12], (DEPTH, Q_W, D_MODEL), Q_W ** -0.5),
        'w_fourier_proj': nrm(ks[13], (DEPTH, F_W, D_MODEL), F_W ** -0.5),
        'w_o': nrm(ks[14], (DEPTH, D_MODEL, D_MODEL), D_MODEL ** -0.5),
        'w_gate_up': nrm(ks[15], (DEPTH, D_MODEL, 2 * D_FF), D_MODEL ** -0.5),
        'w_down': nrm(ks[16], (DEPTH, D_FF, D_MODEL), D_FF ** -0.5),
        'g_final': 1.0 + nrm(ks[17], (D_MODEL,), 0.1),
    }


def reference(x, c, ctx, c_ctx, w_ada, b_ada, g_norm_mix, g_norm_ffn, w_in, b_gate, g_q, g_k,
              w_attn_proj, w_fourier_proj, w_o, w_gate_up, w_down, g_final):
    B, S = x.shape[0], x.shape[1]
    rows = S // GRID_W
    cos, sin = axial_rope_tables(rows, x.dtype)
    cond_lat = c[:, None, :]
    cond_ctx = c_ctx[None, None, :]
    for layer in range(DEPTH):
        last = layer == DEPTH - 1
        w_in_l = w_in[layer]
        sh_m, sc_m, gt_m, sh_f, sc_f, gt_f = adaln(cond_lat, w_ada[layer], b_ada[layer])
        csh_m, csc_m, cgt_m, csh_f, csc_f, cgt_f = adaln(cond_ctx, w_ada[layer], b_ada[layer])

        h_c = modulate(rms_norm(ctx, g_norm_mix[layer]), csh_m, csc_m)
        if last:
            kc, vc = jnp.split(h_c @ w_in_l[:, Q_W:V_END], 2, axis=-1)
        else:
            qc, kc, vc, fc, glc = split_in_proj(h_c @ w_in_l)
        kc = rms_norm(to_heads(kc, N_KV_HEADS), g_k[layer])
        vc = to_heads(vc, N_KV_HEADS)

        h_x = modulate(rms_norm(x, g_norm_mix[layer]), sh_m, sc_m)
        qx, kx, vx, fx, glx = split_in_proj(h_x @ w_in_l)
        qx = apply_rope(rms_norm(to_heads(qx, N_HEADS), g_q[layer]), cos, sin)
        kx = apply_rope(rms_norm(to_heads(kx, N_KV_HEADS), g_k[layer]), cos, sin)
        vx = to_heads(vx, N_KV_HEADS)
        k_all = jnp.concatenate([kc, kx], axis=1)
        v_all = jnp.concatenate([vc, vx], axis=1)
        attn_x = blocked_attention(qx, k_all, v_all)
        mix_x = merge_branches(attn_x, fx, glx, b_gate[layer], w_attn_proj[layer],
                               w_fourier_proj[layer], w_o[layer])
        x = x + gt_m * mix_x
        x = x + gt_f * swiglu(modulate(rms_norm(x, g_norm_ffn[layer]), sh_f, sc_f),
                              w_gate_up[layer], w_down[layer])

        if not last:
            qc = rms_norm(to_heads(qc, N_HEADS), g_q[layer])
            attn_c = blocked_attention(qc, kc, vc)
            mix_c = merge_branches(attn_c, fc, glc, b_gate[layer], w_attn_proj[layer],
                                   w_fourier_proj[layer], w_o[layer])
            ctx = ctx + cgt_m * mix_c
            ctx = ctx + cgt_f * swiglu(modulate(rms_norm(ctx, g_norm_ffn[layer]), csh_f, csc_f),
                                       w_gate_up[layer], w_down[layer])
    return rms_norm(x, g_final)
```

```cpp
#include <hip/hip_runtime.h>
#include <hip/hip_cooperative_groups.h>
#include <cstdio>
#include <cstdint>
namespace cg = cooperative_groups;
namespace pg8 {
#define PG8_LAS __attribute__((address_space(3)))
typedef unsigned short bf16_t;
typedef short bf16x8 __attribute__((ext_vector_type(8)));
typedef float f32x4 __attribute__((ext_vector_type(4)));
typedef unsigned u32x4 __attribute__((ext_vector_type(4)));
constexpr int BM = 256, BK = 64, HALF = 128, HTB = HALF * BK * 2  , STAGE_BYTES = 8 * HTB, NXCD = 8, WGM = 8;

__host__ __device__ __forceinline__ int lds_byte(int r, int c) { const int st = (r >> 4) * 2 + (c >> 5), rr = r & 15, cc = c & 31, ob = rr * 64 + cc * 2; return st * 1024 + (ob ^ (((ob >> 9) & 1) << 5)); }
__host__ __device__ __forceinline__ void stage_rc(int b, int& R, int& C) { const int st = b / 1024, sb = b % 1024, swz = sb ^ (((sb >> 9) & 1) << 5); R = (st >> 1) * 16 + swz / 64; C = (st & 1) * 32 + (swz % 64) / 2; }
__host__ __device__ __forceinline__ int perm32(int rho) { const int n = rho >> 4, i = rho & 15; return 8 * (i >> 2) + 4 * n + (i & 3); }

struct Unit { int pm, pn; };
struct Gemm { const bf16_t* A; const bf16_t* Bt; int M, N, K; };

struct StaticOrder {
    int nM, nN, nwg, G, c;
    __host__ __device__ void init(int M, int N, int G_, int c_) { nM = M / BM; nN = N / BM; nwg = nM * nN; G = G_; c = c_; }
    __host__ __device__ bool next(int i, Unit& u) const {
        const long L = (long)i * G + c; if (L >= nwg) return false;
        int wgid = (int)L; { const int q = nwg / NXCD, r = nwg % NXCD, xcd = wgid % NXCD, off = wgid / NXCD; wgid = (xcd < r ? xcd * (q + 1) : r * (q + 1) + (xcd - r) * q) + off; }
        const int nig = WGM * nN, gid = wgid / nig, fm = gid * WGM, gsz = (nM - fm) < WGM ? (nM - fm) : WGM;
        u.pm = fm + ((wgid % nig) % gsz); u.pn = (wgid % nig) / gsz; return true;
    }
    __device__ __forceinline__ void a_ready(const Unit&) const {}
    __device__ __forceinline__ void done(const Unit&) const {}
};

typedef float f32x2_t __attribute__((ext_vector_type(2))); typedef __bf16 bf16x2_t __attribute__((ext_vector_type(2)));
__device__ __forceinline__ unsigned cvt_pk_bf16(float lo, float hi) { f32x2_t v = {lo, hi}; bf16x2_t b = __builtin_convertvector(v, bf16x2_t); return __builtin_bit_cast(unsigned, b); }
template <class Epi, class Sched, bool ALIGN_EPI = false, bool SP2 = false>
__device__ __forceinline__ void gemm_phase(PG8_LAS unsigned char* lds, const Gemm g, const Sched& S, const Epi& E) {
    int tid_ = threadIdx.x; asm volatile("" : "+v"(tid_));
    const int tid = tid_, wid = __builtin_amdgcn_readfirstlane(tid >> 6), lane = tid & 63, wr = wid >> 2, wc = wid & 3, fr = lane & 15, fq = lane >> 4;
    const int K = g.K, nt = K / BK;
    unsigned voffA[2], voffB[2];
#pragma unroll
    for (int i = 0; i < 2; ++i) { int R, C; stage_rc(tid * 16 + i * 8192, R, C); const int Rb = Epi::PERM ? ((R & ~31) + perm32(R & 31)) : R;
        voffA[i] = (unsigned)(R * K + C) * 2u; voffB[i] = (unsigned)(Rb * K + C) * 2u; }
    const size_t kstep = (size_t)(BK * 2);
    const size_t hstep = (size_t)HALF * K * 2;
    const size_t tstep = 2 * hstep;
    const unsigned ldsw = (unsigned)wid * 1024u;
    const int aoff = lds_byte(wr * 64 + fr, fq * 8), boff = lds_byte(wc * 32 + fr, fq * 8);
#define PG8_SA(b, h) (((b) * 2 + (h)) * HTB)
#define PG8_SB(b, h) ((4 + (b) * 2 + (h)) * HTB)
#define PG8_STAGE(bufoff, gbase, voff) do { _Pragma("unroll") for (int _i = 0; _i < 2; ++_i) \
        __builtin_amdgcn_global_load_lds((const unsigned*)((const char*)(gbase) + (voff)[_i]), (PG8_LAS unsigned*)(lds + (bufoff) + ldsw + _i * 8192), 16, 0, 0); } while (0)
#define PG8_LDA(dst, b, h) do { _Pragma("unroll") for (int m = 0; m < 4; ++m) _Pragma("unroll") for (int k = 0; k < 2; ++k) dst[m][k] = *(const PG8_LAS bf16x8*)(lds + PG8_SA(b, h) + aoff + m * 2048 + k * 1024); } while (0)
#define PG8_LDB(dst, b, h) do { _Pragma("unroll") for (int n = 0; n < 2; ++n) _Pragma("unroll") for (int k = 0; k < 2; ++k) dst[n][k] = *(const PG8_LAS bf16x8*)(lds + PG8_SB(b, h) + boff + n * 2048 + k * 1024); } while (0)
#define PG8_MMA(ai, bj, At, Bt) do { __builtin_amdgcn_s_setprio(1); _Pragma("unroll") for (int m = 0; m < 4; ++m) _Pragma("unroll") for (int n = 0; n < 2; ++n) _Pragma("unroll") for (int k = 0; k < 2; ++k) \
        acc[ai][bj][m][n] = __builtin_amdgcn_mfma_f32_16x16x32_bf16(Bt[n][k], At[m][k], acc[ai][bj][m][n], 0, 0, 0); __builtin_amdgcn_s_setprio(0); } while (0)
#define PG8_WAIT_V(n) asm volatile("s_waitcnt vmcnt(" #n ")" ::: "memory")
#define PG8_WAIT_L(n) asm volatile("s_waitcnt lgkmcnt(" #n ")" ::: "memory")
#define PG8_BAR __builtin_amdgcn_s_barrier()
#define PG8_SCHED __builtin_amdgcn_sched_barrier(0)
    Unit cur, nxt; int ui = 0;
    if (!S.next(0, cur)) return;
    f32x4 acc[2][2][4][2];
#pragma unroll
    for (int a = 0; a < 2; ++a)
#pragma unroll
        for (int b = 0; b < 2; ++b)
#pragma unroll
            for (int m = 0; m < 4; ++m)
#pragma unroll
                for (int n = 0; n < 2; ++n) acc[a][b][m][n] = (f32x4){0.f, 0.f, 0.f, 0.f};
    bf16x8 At[4][2], B0[2][2], B1[2][2];
    const char* cA = (const char*)g.A + (size_t)cur.pm * tstep; const char* cB = (const char*)g.Bt + (size_t)cur.pn * tstep;
    S.a_ready(cur);
    if constexpr (SP2) {
        PG8_STAGE(PG8_SB(0, 0), cB, voffB); PG8_STAGE(PG8_SB(0, 1), cB + hstep, voffB); PG8_STAGE(PG8_SA(0, 0), cA, voffA); PG8_STAGE(PG8_SA(0, 1), cA + hstep, voffA);
        if (wr == 1) PG8_BAR;
        PG8_WAIT_V(2); PG8_BAR;
        PG8_STAGE(PG8_SB(1, 0), cB + kstep, voffB); PG8_STAGE(PG8_SA(1, 0), cA + kstep, voffA); PG8_STAGE(PG8_SB(1, 1), cB + hstep + kstep, voffB);
        PG8_WAIT_V(6); PG8_BAR;
    } else {
        PG8_STAGE(PG8_SB(0, 0), cB, voffB); PG8_STAGE(PG8_SA(0, 0), cA, voffA); PG8_STAGE(PG8_SB(0, 1), cB + hstep, voffB); PG8_STAGE(PG8_SA(0, 1), cA + hstep, voffA);
        if (wr == 1) PG8_BAR;
        PG8_WAIT_V(4); PG8_BAR;
        PG8_STAGE(PG8_SB(1, 0), cB + kstep, voffB); PG8_STAGE(PG8_SA(1, 0), cA + kstep, voffA); PG8_STAGE(PG8_SB(1, 1), cB + hstep + kstep, voffB);
        PG8_WAIT_V(6); PG8_BAR;
    }
    for (;;) {
        const bool has_next = S.next(ui + 1, nxt);
        const char* nA = has_next ? (const char*)g.A + (size_t)nxt.pm * tstep : cA; const char* nB = has_next ? (const char*)g.Bt + (size_t)nxt.pn * tstep : cB;
        for (int t = 0; t < nt; t += 2) {
            const bool last = (t == nt - 2);
            const char* a1 = cA + (size_t)(t + 1) * kstep;
            const char* a2 = last ? nA : cA + (size_t)(t + 2) * kstep; const char* b2 = last ? nB : cB + (size_t)(t + 2) * kstep;
            const char* a3 = a2 + kstep; const char* b3 = b2 + kstep;
            if (last && has_next) S.a_ready(nxt);
            if constexpr (SP2) {
            PG8_LDB(B0, 0, 0); PG8_LDB(B1, 0, 1); PG8_SCHED; PG8_LDA(At, 0, 0); PG8_STAGE(PG8_SA(1, 1), a1 + hstep, voffA);
            PG8_WAIT_V(8); PG8_WAIT_L(0); PG8_BAR; PG8_MMA(0, 0, At, B0); PG8_MMA(0, 1, At, B1); PG8_BAR; PG8_SCHED;
            PG8_LDA(At, 0, 1); PG8_STAGE(PG8_SB(0, 0), b2, voffB); PG8_STAGE(PG8_SB(0, 1), b2 + hstep, voffB); PG8_STAGE(PG8_SA(0, 0), a2, voffA);
            PG8_WAIT_V(8); PG8_WAIT_L(0); PG8_BAR; PG8_MMA(1, 0, At, B0); PG8_MMA(1, 1, At, B1); PG8_BAR; PG8_SCHED;
            PG8_LDB(B0, 1, 0); PG8_LDB(B1, 1, 1); PG8_SCHED; PG8_LDA(At, 1, 0); PG8_STAGE(PG8_SA(0, 1), a2 + hstep, voffA);
            PG8_WAIT_V(8); PG8_WAIT_L(0); PG8_BAR; PG8_MMA(0, 0, At, B0); PG8_MMA(0, 1, At, B1); PG8_BAR; PG8_SCHED;
            PG8_LDA(At, 1, 1); PG8_STAGE(PG8_SB(1, 0), b3, voffB); PG8_STAGE(PG8_SB(1, 1), b3 + hstep, voffB); PG8_STAGE(PG8_SA(1, 0), a3, voffA);
            PG8_WAIT_V(8); PG8_WAIT_L(0); PG8_BAR; PG8_MMA(1, 0, At, B0); PG8_MMA(1, 1, At, B1); PG8_BAR; PG8_SCHED;
            } else {
            PG8_LDB(B0, 0, 0); PG8_SCHED; PG8_LDA(At, 0, 0); PG8_STAGE(PG8_SA(1, 1), a1 + hstep, voffA);
            PG8_WAIT_L(8); PG8_BAR; PG8_WAIT_L(0); PG8_MMA(0, 0, At, B0); PG8_BAR; PG8_SCHED;
            PG8_LDB(B1, 0, 1); PG8_STAGE(PG8_SB(0, 0), b2, voffB);
            PG8_BAR; PG8_WAIT_L(0); PG8_MMA(0, 1, At, B1); PG8_BAR;
            PG8_LDA(At, 0, 1); PG8_STAGE(PG8_SA(0, 0), a2, voffA);
            PG8_BAR; PG8_WAIT_L(0); PG8_MMA(1, 0, At, B0); PG8_BAR; PG8_SCHED;
            PG8_STAGE(PG8_SB(0, 1), b2 + hstep, voffB);
            PG8_WAIT_V(6); PG8_BAR; PG8_MMA(1, 1, At, B1); PG8_BAR;
            PG8_LDB(B0, 1, 0); PG8_SCHED; PG8_LDA(At, 1, 0); PG8_STAGE(PG8_SA(0, 1), a2 + hstep, voffA);
            PG8_WAIT_L(8); PG8_BAR; PG8_WAIT_L(0); PG8_MMA(0, 0, At, B0); PG8_BAR; PG8_SCHED;
            PG8_LDB(B1, 1, 1); PG8_STAGE(PG8_SB(1, 0), b3, voffB);
            PG8_BAR; PG8_WAIT_L(0); PG8_MMA(0, 1, At, B1); PG8_BAR;
            PG8_LDA(At, 1, 1); PG8_STAGE(PG8_SA(1, 0), a3, voffA);
            PG8_BAR; PG8_WAIT_L(0); PG8_MMA(1, 0, At, B0); PG8_BAR; PG8_SCHED;
            PG8_STAGE(PG8_SB(1, 1), b3 + hstep, voffB);
            PG8_WAIT_V(6); PG8_BAR; PG8_MMA(1, 1, At, B1); PG8_BAR;
            }
        }
        if constexpr (ALIGN_EPI) { if (wr == 0) PG8_BAR; }
        if constexpr (!Epi::AFTER_DRAIN) { E(acc, cur, wr, wc, fr, fq); S.done(cur); }
        if (!has_next) break;
#pragma unroll
        for (int a = 0; a < 2; ++a)
#pragma unroll
            for (int b = 0; b < 2; ++b)
#pragma unroll
                for (int m = 0; m < 4; ++m)
#pragma unroll
                    for (int n = 0; n < 2; ++n) acc[a][b][m][n] = (f32x4){0.f, 0.f, 0.f, 0.f};
        cur = nxt; cA = nA; cB = nB; ++ui;
        if constexpr (ALIGN_EPI) { if (wr == 1) PG8_BAR; }
    }
    PG8_WAIT_V(0);
    if constexpr (!ALIGN_EPI) { if (wr == 0) PG8_BAR; }
    PG8_BAR;
    if constexpr (Epi::AFTER_DRAIN) { E.fused(acc, cur, wr, wc, fr, fq, lds, wid, lane); S.done(cur); }
#undef PG8_SA
#undef PG8_SB
#undef PG8_STAGE
#undef PG8_LDA
#undef PG8_LDB
#undef PG8_MMA
#undef PG8_WAIT_V
#undef PG8_WAIT_L
#undef PG8_BAR
#undef PG8_SCHED
}
}

using pg8::bf16_t; using pg8::f32x4; using pg8::u32x4; using pg8::bf16x8; using pg8::Unit; using pg8::cvt_pk_bf16;
#define LAS __attribute__((address_space(3)))
typedef float f32x16 __attribute__((ext_vector_type(16)));
typedef short s16x4 __attribute__((ext_vector_type(4)));
typedef unsigned u32x2 __attribute__((ext_vector_type(2)));
typedef float f32x2v __attribute__((ext_vector_type(2)));

constexpr int S_ = 2048, DM = 1024, CTXL = 256, SALL = S_ + CTXL;
constexpr int MTOK = 8 * S_, MCTX = 8 * CTXL, MALL = MTOK + MCTX;
constexpr int INW = 4096, NIN = 4608, DFF = 2816, NGU = 5632;
constexpr float EPS = 1e-6f;
constexpr float LOG2E = 1.4426950408889634f;
constexpr float C2 = 0.125f * LOG2E;
constexpr int NTHREADS = 512;
constexpr int LDS_BYTES = 131072 + 64;

constexpr size_t MiB = 1u << 20;
constexpr size_t WS_MOD = 1 * MiB;
constexpr size_t WS_ROPE = WS_MOD + 256 * 1024;
constexpr size_t WS_BIAS2 = WS_ROPE + 512 * 1024;
constexpr size_t WS_SS1 = 2 * MiB;
constexpr size_t WS_SS2 = 3 * MiB;
constexpr size_t WS_PART = 4 * MiB;
constexpr size_t WS_WIN = 11 * MiB;
constexpr size_t WS_WAP = 20 * MiB;
constexpr size_t WS_WFP = 240 * MiB;
constexpr size_t WS_WO = 23 * MiB;
constexpr size_t WS_WGU = 25 * MiB;
constexpr size_t WS_WDN = 36 * MiB;
constexpr size_t WS_D = 42 * MiB;
constexpr size_t WS_H = 58 * MiB;
constexpr size_t WS_Y = WS_H;
constexpr size_t WS_Q = 94 * MiB;
constexpr size_t WS_K = 126 * MiB;
constexpr size_t WS_VT = 135 * MiB;
constexpr size_t WS_UVT = 144 * MiB;
constexpr size_t WS_MG = WS_UVT;
constexpr size_t WS_G = 176 * MiB;
constexpr size_t WS_A2 = WS_G;
constexpr size_t WS_ACT = 58 * MiB;
constexpr size_t WS_END = 242 * MiB;

struct Params { const float* in[18]; float* out; unsigned char* ws; };

__device__ __forceinline__ float wave_sum(float v) {
#pragma unroll
    for (int o = 1; o < 64; o <<= 1) v += __shfl_xor(v, o);
    return v;
}
__device__ __forceinline__ float sigmoid_(float v) { return __builtin_amdgcn_rcpf(1.f + __builtin_amdgcn_exp2f(-LOG2E * v)); }
__device__ __forceinline__ float bf_lo(unsigned w) { return __uint_as_float(w << 16); }
__device__ __forceinline__ float bf_hi(unsigned w) { return __uint_as_float(w & 0xffff0000u); }
__device__ __forceinline__ u32x4 pack8(const f32x4 a, const f32x4 b) { u32x4 w; w.x = cvt_pk_bf16(a[0], a[1]); w.y = cvt_pk_bf16(a[2], a[3]); w.z = cvt_pk_bf16(b[0], b[1]); w.w = cvt_pk_bf16(b[2], b[3]); return w; }
__device__ __forceinline__ unsigned short bf1(float v) { return (unsigned short)(cvt_pk_bf16(v, v) & 0xffffu); }

struct EpiIn {
    static constexpr bool PERM = true, AFTER_DRAIN = false;
    bf16_t *Q, *K, *VT, *UVT, *G; const float *gq, *gk, *bgate; const f32x2v* rope;
    __device__ __forceinline__ void operator()(const f32x4 (&acc)[2][2][4][2], const Unit& u, int wr, int wc, int fr, int fq) const {
        const int pn = u.pn; const bool isctx = u.pm >= 64;
        if (pn < 5) {
            const bool isq = pn < 4; const float* g = isq ? gq : gk; const float osc = isq ? C2 : 1.f;
            f32x4 gv[2][2];
#pragma unroll
            for (int bj = 0; bj < 2; ++bj)
#pragma unroll
                for (int n = 0; n < 2; ++n) gv[bj][n] = *(const f32x4*)(g + 32 * bj + 8 * fq + 4 * n);
#pragma unroll
            for (int ai = 0; ai < 2; ++ai)
#pragma unroll
                for (int m = 0; m < 4; ++m) {
                    const int r = u.pm * 256 + ai * 128 + wr * 64 + m * 16 + fr;
                    f32x4 v[2][2]; float ss = 0.f;
#pragma unroll
                    for (int bj = 0; bj < 2; ++bj)
#pragma unroll
                        for (int n = 0; n < 2; ++n) { v[bj][n] = acc[ai][bj][m][n]; const f32x4 t = v[bj][n]; ss += (t[0] * t[0] + t[1] * t[1]) + (t[2] * t[2] + t[3] * t[3]); }
                    ss += __shfl_xor(ss, 16); ss += __shfl_xor(ss, 32);
                    const float rs = __builtin_amdgcn_rsqf(ss * (1.f / 64.f) + EPS);
#pragma unroll
                    for (int bj = 0; bj < 2; ++bj)
#pragma unroll
                        for (int n = 0; n < 2; ++n) v[bj][n] = v[bj][n] * rs * gv[bj][n];
                    f32x4 o1[2], o2[2];
                    bf16_t* base;
                    if (!isctx) {
                        const int s = r & 2047; const f32x2v* rp = rope + s * 32 + 8 * fq;
#pragma unroll
                        for (int n = 0; n < 2; ++n)
#pragma unroll
                            for (int j = 0; j < 4; ++j) { const f32x2v cs = rp[4 * n + j]; o1[n][j] = (v[0][n][j] * cs.x - v[1][n][j] * cs.y) * osc; o2[n][j] = (v[1][n][j] * cs.x + v[0][n][j] * cs.y) * osc; }
                        base = isq ? Q + (size_t)r * 1024 + 64 * (4 * pn + wc) : K + ((size_t)(r >> 11) * SALL + CTXL + s) * 256 + 64 * wc;
                    } else {
                        o1[0] = v[0][0]; o1[1] = v[0][1]; o2[0] = v[1][0]; o2[1] = v[1][1];
                        const int rc = r - MTOK; base = K + ((size_t)(rc >> 8) * SALL + (rc & 255)) * 256 + 64 * wc;
                    }
                    *(u32x4*)(base + 8 * fq) = pack8(o1[0], o1[1]);
                    *(u32x4*)(base + 32 + 8 * fq) = pack8(o2[0], o2[1]);
                }
        } else if (pn == 5) {
#pragma unroll
            for (int ai = 0; ai < 2; ++ai)
#pragma unroll
                for (int m = 0; m < 4; ++m) {
                    const int r = u.pm * 256 + ai * 128 + wr * 64 + m * 16 + fr;
                    int b, pos; if (!isctx) { b = r >> 11; pos = CTXL + (r & 2047); } else { const int rc = r - MTOK; b = rc >> 8; pos = rc & 255; }
#pragma unroll
                    for (int bj = 0; bj < 2; ++bj) {
                        const int c0 = 128 * bj + 32 * wc + 8 * fq; const int kvh = c0 >> 6, d0 = c0 & 63;
                        bf16_t* vp = VT + ((size_t)(b * 4 + kvh) * 64 + d0) * SALL + pos;
#pragma unroll
                        for (int n = 0; n < 2; ++n)
#pragma unroll
                            for (int j = 0; j < 4; ++j) vp[(size_t)(4 * n + j) * SALL] = bf1(acc[ai][bj][m][n][j]);
                    }
                }
        } else if (pn < 10) {
            const int half = (pn - 6) >> 1; const int chb = 256 * ((pn - 6) & 1);
#pragma unroll
            for (int ai = 0; ai < 2; ++ai)
#pragma unroll
                for (int m = 0; m < 4; ++m) {
                    const int r = u.pm * 256 + ai * 128 + wr * 64 + m * 16 + fr;
                    const int b = r >> 11, s = r & 2047;
#pragma unroll
                    for (int bj = 0; bj < 2; ++bj) {
                        const int ch0 = chb + 128 * bj + 32 * wc + 8 * fq;
                        bf16_t* up = UVT + ((size_t)((half * 8 + b) * 512 + ch0)) * 2048 + s;
#pragma unroll
                        for (int n = 0; n < 2; ++n)
#pragma unroll
                            for (int j = 0; j < 4; ++j) up[(size_t)(4 * n + j) * 2048] = bf1(acc[ai][bj][m][n][j]);
                    }
                }
        } else {
            const int col0 = 256 * (pn - 10) + 32 * wc + 8 * fq;
            f32x4 bv[2][2];
#pragma unroll
            for (int bj = 0; bj < 2; ++bj)
#pragma unroll
                for (int n = 0; n < 2; ++n) bv[bj][n] = *(const f32x4*)(bgate + col0 + 128 * bj + 4 * n);
#pragma unroll
            for (int ai = 0; ai < 2; ++ai)
#pragma unroll
                for (int m = 0; m < 4; ++m) {
                    const int r = u.pm * 256 + ai * 128 + wr * 64 + m * 16 + fr;
#pragma unroll
                    for (int bj = 0; bj < 2; ++bj) {
                        f32x4 a = acc[ai][bj][m][0] + bv[bj][0], c = acc[ai][bj][m][1] + bv[bj][1];
#pragma unroll
                        for (int j = 0; j < 4; ++j) { a[j] = sigmoid_(a[j]); c[j] = sigmoid_(c[j]); }
                        *(u32x4*)(G + (size_t)r * 2048 + col0 + 128 * bj) = pack8(a, c);
                    }
                }
        }
    }
};

struct EpiY {
    static constexpr bool PERM = true, AFTER_DRAIN = false;
    bf16_t* Y;
    __device__ __forceinline__ void operator()(const f32x4 (&acc)[2][2][4][2], const Unit& u, int wr, int wc, int fr, int fq) const {
        const int kh = u.pn >> 4, pn = u.pn & 15, pm = u.pm & 7;
        const int b = pn >> 1; const int col0 = 512 * kh + 256 * (pn & 1) + 32 * wc + 8 * fq;
#pragma unroll
        for (int ai = 0; ai < 2; ++ai)
#pragma unroll
            for (int m = 0; m < 4; ++m) {
                const int row = b * 2048 + pm * 256 + ai * 128 + wr * 64 + m * 16 + fr;
#pragma unroll
                for (int bj = 0; bj < 2; ++bj) *(u32x4*)(Y + (size_t)row * 1024 + col0 + 128 * bj) = pack8(acc[ai][bj][m][0], acc[ai][bj][m][1]);
            }
    }
};

struct EpiGateF {
    static constexpr bool PERM = true, AFTER_DRAIN = false;
    const bf16_t* G; bf16_t* MG;
    __device__ __forceinline__ void operator()(const f32x4 (&acc)[2][2][4][2], const Unit& u, int wr, int wc, int fr, int fq) const {
        const int col0 = 256 * u.pn + 32 * wc + 8 * fq;
#pragma unroll
        for (int ai = 0; ai < 2; ++ai)
#pragma unroll
            for (int m = 0; m < 4; ++m) {
                const int r = u.pm * 256 + ai * 128 + wr * 64 + m * 16 + fr;
#pragma unroll
                for (int bj = 0; bj < 2; ++bj) {
                    const int col = col0 + 128 * bj;
                    const u32x4 gw = *(const u32x4*)(G + (size_t)r * 2048 + 1024 + col);
                    const f32x4 g0 = {bf_lo(gw.x), bf_hi(gw.x), bf_lo(gw.y), bf_hi(gw.y)}, g1 = {bf_lo(gw.z), bf_hi(gw.z), bf_lo(gw.w), bf_hi(gw.w)};
                    *(u32x4*)(MG + (size_t)r * 1024 + col) = pack8(acc[ai][bj][m][0] * g0, acc[ai][bj][m][1] * g1);
                }
            }
    }
};
struct EpiGateA {
    static constexpr bool PERM = true, AFTER_DRAIN = false;
    const bf16_t* G; bf16_t* MG;
    __device__ __forceinline__ void operator()(const f32x4 (&acc)[2][2][4][2], const Unit& u, int wr, int wc, int fr, int fq) const {
        const int col0 = 256 * u.pn + 32 * wc + 8 * fq;
#pragma unroll
        for (int ai = 0; ai < 2; ++ai)
#pragma unroll
            for (int m = 0; m < 4; ++m) {
                const int r = u.pm * 256 + ai * 128 + wr * 64 + m * 16 + fr;
#pragma unroll
                for (int bj = 0; bj < 2; ++bj) {
                    const int col = col0 + 128 * bj;
                    const u32x4 gw = *(const u32x4*)(G + (size_t)r * 2048 + col);
                    const u32x4 tw = *(const u32x4*)(MG + (size_t)r * 1024 + col);
                    const f32x4 g0 = {bf_lo(gw.x), bf_hi(gw.x), bf_lo(gw.y), bf_hi(gw.y)}, g1 = {bf_lo(gw.z), bf_hi(gw.z), bf_lo(gw.w), bf_hi(gw.w)};
                    const f32x4 t0 = {bf_lo(tw.x), bf_hi(tw.x), bf_lo(tw.y), bf_hi(tw.y)}, t1 = {bf_lo(tw.z), bf_hi(tw.z), bf_lo(tw.w), bf_hi(tw.w)};
                    *(u32x4*)(MG + (size_t)r * 1024 + col) = pack8(t0 + acc[ai][bj][m][0] * g0, t1 + acc[ai][bj][m][1] * g1);
                }
            }
    }
};


constexpr int O_TILE_OFF = (int)((WS_Q - WS_Y) / (256 * 1024 * 2));
constexpr int WFP_TILE_OFF = (int)((WS_WFP - WS_WAP) / (256 * 1024 * 2));
static_assert((WS_Q - WS_Y) % (256 * 1024 * 2) == 0 && (WS_WFP - WS_WAP) % (256 * 1024 * 2) == 0, "tile-aligned buffer offsets");
struct EpiMerge {
    static constexpr bool PERM = true, AFTER_DRAIN = false;
    EpiGateF F; EpiGateA A;
    __device__ __forceinline__ void operator()(const f32x4 (&acc)[2][2][4][2], const Unit& u, int wr, int wc, int fr, int fq) const {
        if (u.pn >= WFP_TILE_OFF) { const Unit v{u.pm, u.pn - WFP_TILE_OFF}; F(acc, v, wr, wc, fr, fq); }
        else { const Unit v{u.pm - O_TILE_OFF, u.pn}; A(acc, v, wr, wc, fr, fq); }
    }
};
struct SchedMerge {
    pg8::StaticOrder so;
    __device__ bool next(int i, Unit& u) const { if (!so.next(i >> 1, u)) return false; if (i & 1) u.pm += O_TILE_OFF; else u.pn += WFP_TILE_OFF; return true; }
    __device__ __forceinline__ void a_ready(const Unit&) const {}
    __device__ __forceinline__ void done(const Unit&) const {}
};

struct EpiWo {
    static constexpr bool PERM = true, AFTER_DRAIN = false;
    const float *x, *mod, *gnf; float* X1; bf16_t* A2; float* SS;
    __device__ __forceinline__ void operator()(const f32x4 (&acc)[2][2][4][2], const Unit& u, int wr, int wc, int fr, int fq) const {
        const int b = u.pm >> 3; const int col0 = 256 * u.pn + 32 * wc + 8 * fq;
        f32x4 gt[2][2], gm[2][2];
#pragma unroll
        for (int bj = 0; bj < 2; ++bj)
#pragma unroll
            for (int n = 0; n < 2; ++n) { const int col = col0 + 128 * bj + 4 * n;
                gt[bj][n] = *(const f32x4*)(mod + b * 6144 + 2 * 1024 + col);
                gm[bj][n] = *(const f32x4*)(gnf + col) * (*(const f32x4*)(mod + b * 6144 + 4 * 1024 + col) + 1.f); }
#pragma unroll
        for (int ai = 0; ai < 2; ++ai)
#pragma unroll
            for (int m = 0; m < 4; ++m) {
                const int r = u.pm * 256 + ai * 128 + wr * 64 + m * 16 + fr; float ss = 0.f;
#pragma unroll
                for (int bj = 0; bj < 2; ++bj) {
                    const size_t off = (size_t)r * 1024 + col0 + 128 * bj;
                    const f32x4 x0 = *(const f32x4*)(x + off) + gt[bj][0] * acc[ai][bj][m][0], x1 = *(const f32x4*)(x + off + 4) + gt[bj][1] * acc[ai][bj][m][1];
                    ss += (x0[0] * x0[0] + x0[1] * x0[1]) + (x0[2] * x0[2] + x0[3] * x0[3]) + (x1[0] * x1[0] + x1[1] * x1[1]) + (x1[2] * x1[2] + x1[3] * x1[3]);
                    *(f32x4*)(X1 + off) = x0; *(f32x4*)(X1 + off + 4) = x1;
                    *(u32x4*)(A2 + off) = pack8(x0 * gm[bj][0], x1 * gm[bj][1]);
                }
                ss += __shfl_xor(ss, 16); ss += __shfl_xor(ss, 32);
                if (fq == 0) SS[(size_t)r * 16 + 4 * u.pn + wc] = ss;
            }
    }
};

struct EpiGU {
    static constexpr bool PERM = true, AFTER_DRAIN = false;
    const float *SS, *bias2; bf16_t* ACT;
    __device__ __forceinline__ void operator()(const f32x4 (&acc)[2][2][4][2], const Unit& u, int wr, int wc, int fr, int fq) const {
        const int b = u.pm >> 3; const int c0 = 128 * u.pn + 32 * wc + 8 * fq;
        f32x4 bg[2], bu[2];
#pragma unroll
        for (int n = 0; n < 2; ++n) { bg[n] = *(const f32x4*)(bias2 + b * NGU + c0 + 4 * n); bu[n] = *(const f32x4*)(bias2 + b * NGU + DFF + c0 + 4 * n); }
#pragma unroll
        for (int ai = 0; ai < 2; ++ai)
#pragma unroll
            for (int m = 0; m < 4; ++m) {
                const int r = u.pm * 256 + ai * 128 + wr * 64 + m * 16 + fr;
                const f32x4* sp = (const f32x4*)(SS + (size_t)r * 16);
                const f32x4 s4 = (sp[0] + sp[1]) + (sp[2] + sp[3]);
                const float rs = __builtin_amdgcn_rsqf(((s4[0] + s4[1]) + (s4[2] + s4[3])) * (1.f / 1024.f) + EPS);
                f32x4 o[2];
#pragma unroll
                for (int n = 0; n < 2; ++n) { const f32x4 g = acc[ai][0][m][n] * rs + bg[n], up = acc[ai][1][m][n] * rs + bu[n];
#pragma unroll
                    for (int j = 0; j < 4; ++j) o[n][j] = g[j] * sigmoid_(g[j]) * up[j]; }
                *(u32x4*)(ACT + (size_t)r * DFF + c0) = pack8(o[0], o[1]);
            }
    }
};

struct EpiDown {
    static constexpr bool PERM = true, AFTER_DRAIN = false;
    const float* mod; float* X; float* SS;
    __device__ __forceinline__ void operator()(const f32x4 (&acc)[2][2][4][2], const Unit& u, int wr, int wc, int fr, int fq) const {
        const int b = u.pm >> 3; const int col0 = 256 * u.pn + 32 * wc + 8 * fq;
        f32x4 gt[2][2];
#pragma unroll
        for (int bj = 0; bj < 2; ++bj)
#pragma unroll
            for (int n = 0; n < 2; ++n) gt[bj][n] = *(const f32x4*)(mod + b * 6144 + 5 * 1024 + col0 + 128 * bj + 4 * n);
#pragma unroll
        for (int ai = 0; ai < 2; ++ai)
#pragma unroll
            for (int m = 0; m < 4; ++m) {
                const int r = u.pm * 256 + ai * 128 + wr * 64 + m * 16 + fr; float ss = 0.f;
#pragma unroll
                for (int bj = 0; bj < 2; ++bj) {
                    const size_t off = (size_t)r * 1024 + col0 + 128 * bj;
                    const f32x4 x0 = *(const f32x4*)(X + off) + gt[bj][0] * acc[ai][bj][m][0], x1 = *(const f32x4*)(X + off + 4) + gt[bj][1] * acc[ai][bj][m][1];
                    ss += (x0[0] * x0[0] + x0[1] * x0[1]) + (x0[2] * x0[2] + x0[3] * x0[3]) + (x1[0] * x1[0] + x1[1] * x1[1]) + (x1[2] * x1[2] + x1[3] * x1[3]);
                    *(f32x4*)(X + off) = x0; *(f32x4*)(X + off + 4) = x1;
                }
                ss += __shfl_xor(ss, 16); ss += __shfl_xor(ss, 32);
                if (fq == 0) SS[(size_t)r * 16 + 4 * u.pn + wc] = ss;
            }
    }
};


struct EpiDownFused {
    static constexpr bool PERM = true, AFTER_DRAIN = true;
    const float* mod; float* X; float* SS; unsigned* cnt; const float* gfin;
    __device__ __forceinline__ void fused(f32x4 (&acc)[2][2][4][2], const Unit& u, int wr, int wc, int fr, int fq, LAS unsigned char* lds, int wid, int lane) const {
        const int b = u.pm >> 3; const int col0 = 256 * u.pn + 32 * wc + 8 * fq;
        {
            f32x4 gt[2][2];
#pragma unroll
            for (int bj = 0; bj < 2; ++bj)
#pragma unroll
                for (int n = 0; n < 2; ++n) gt[bj][n] = *(const f32x4*)(mod + b * 6144 + 5 * 1024 + col0 + 128 * bj + 4 * n);
#pragma unroll
            for (int ai = 0; ai < 2; ++ai)
#pragma unroll
                for (int m = 0; m < 4; ++m) {
                    const int r = u.pm * 256 + ai * 128 + wr * 64 + m * 16 + fr; float ss = 0.f;
#pragma unroll
                    for (int bj = 0; bj < 2; ++bj) {
                        const size_t off = (size_t)r * 1024 + col0 + 128 * bj;
                        const f32x4 x0 = *(const f32x4*)(X + off) + gt[bj][0] * acc[ai][bj][m][0], x1 = *(const f32x4*)(X + off + 4) + gt[bj][1] * acc[ai][bj][m][1];
                        ss += (x0[0] * x0[0] + x0[1] * x0[1]) + (x0[2] * x0[2] + x0[3] * x0[3]) + (x1[0] * x1[0] + x1[1] * x1[1]) + (x1[2] * x1[2] + x1[3] * x1[3]);
                        acc[ai][bj][m][0] = x0; acc[ai][bj][m][1] = x1;
                    }
                    ss += __shfl_xor(ss, 16); ss += __shfl_xor(ss, 32);
                    if (fq == 0) __hip_atomic_store(SS + (size_t)r * 16 + 4 * u.pn + wc, ss, __ATOMIC_RELAXED, __HIP_MEMORY_SCOPE_AGENT);
                }
        }
        asm volatile("s_waitcnt vmcnt(0)" ::: "memory");
        unsigned* cw = cnt + 64 * u.pm;
        if (lane == 0) __hip_atomic_fetch_add(cw, 1u, __ATOMIC_RELAXED, __HIP_MEMORY_SCOPE_AGENT);
        if (wid == 0) {
            unsigned sp = 0;
            while ((unsigned)__builtin_amdgcn_readfirstlane(__hip_atomic_load(cw, __ATOMIC_RELAXED, __HIP_MEMORY_SCOPE_AGENT)) < 32u) { __builtin_amdgcn_s_sleep(2); if (++sp > (1u << 22)) break; }
            __builtin_amdgcn_fence(__ATOMIC_ACQUIRE, "agent");
        }
        asm volatile("s_waitcnt vmcnt(0) lgkmcnt(0)" ::: "memory"); __builtin_amdgcn_s_barrier(); asm volatile("" ::: "memory");
        LAS float* rsl = (LAS float*)lds;
        { const int t = wid * 64 + lane;
          if (t < 256) { const float* sp = SS + (size_t)(u.pm * 256 + t) * 16; float s = 0.f;
#pragma unroll
              for (int q = 0; q < 16; ++q) s += __hip_atomic_load(sp + q, __ATOMIC_RELAXED, __HIP_MEMORY_SCOPE_AGENT);
              rsl[t] = __builtin_amdgcn_rsqf(s * (1.f / 1024.f) + EPS); } }
        asm volatile("s_waitcnt vmcnt(0) lgkmcnt(0)" ::: "memory"); __builtin_amdgcn_s_barrier(); asm volatile("" ::: "memory");
        f32x4 gf[2][2];
#pragma unroll
        for (int bj = 0; bj < 2; ++bj)
#pragma unroll
            for (int n = 0; n < 2; ++n) gf[bj][n] = *(const f32x4*)(gfin + col0 + 128 * bj + 4 * n);
#pragma unroll
        for (int ai = 0; ai < 2; ++ai)
#pragma unroll
            for (int m = 0; m < 4; ++m) {
                const int rl = ai * 128 + wr * 64 + m * 16 + fr; const float rs = rsl[rl];
#pragma unroll
                for (int bj = 0; bj < 2; ++bj) {
                    const size_t off = (size_t)(u.pm * 256 + rl) * 1024 + col0 + 128 * bj;
                    *(f32x4*)(X + off) = acc[ai][bj][m][0] * rs * gf[bj][0]; *(f32x4*)(X + off + 4) = acc[ai][bj][m][1] * rs * gf[bj][1];
                }
            }
    }
};

struct EpiNull {
    static constexpr bool PERM = true, AFTER_DRAIN = false;
    float* sink;
    __device__ __forceinline__ void operator()(const f32x4 (&acc)[2][2][4][2], const Unit& u, int wr, int wc, int fr, int fq) const {
        if (acc[0][0][0][0][0] == 123456.789f) sink[0] = 1.f;
    }
};
struct SchedIn {
    pg8::StaticOrder so;
    __device__ void init(int G, int c) { so.init(MTOK, NIN, G, c); }
    __device__ bool next(int i, Unit& u) const {
        const long L = (long)i * so.G + so.c; if (L < so.nwg) return so.next(i, u);
        const int xx = (int)(L - so.nwg); if (xx >= 16) return false; u.pm = 64 + (xx >> 1); u.pn = 4 + (xx & 1); return true; }
    __device__ __forceinline__ void a_ready(const Unit&) const {}
    __device__ __forceinline__ void done(const Unit&) const {}
};
struct SchedFour {
    int G, c;
    __device__ bool next(int i, Unit& u) const { const long L = (long)i * G + c; if (L >= 256) return false; const int x = (int)L & 7, j = (int)L >> 3; const int kh = x >> 2;
        u.pm = kh * 8 + (j & 7); u.pn = kh * 16 + 4 * (x & 3) + (j >> 3); return true; }
    __device__ __forceinline__ void a_ready(const Unit&) const {}
    __device__ __forceinline__ void done(const Unit&) const {}
};

constexpr int KPITCH = 144, VPITCH = 136, KBUF = 64 * KPITCH, VBUF = 64 * VPITCH;
__device__ __forceinline__ void attn_qk(f32x16& sA, f32x16& sB, const LAS unsigned char* kb, const bf16x8 (&qr)[4], const f32x16& negm) {
#pragma unroll
    for (int ks = 0; ks < 4; ++ks) {
        const bf16x8 a0 = *(const LAS bf16x8*)(kb + ks * 32), a1 = *(const LAS bf16x8*)(kb + 32 * KPITCH + ks * 32);
        if (ks == 0) { sA = __builtin_amdgcn_mfma_f32_32x32x16_bf16(a0, qr[0], negm, 0, 0, 0); sB = __builtin_amdgcn_mfma_f32_32x32x16_bf16(a1, qr[0], negm, 0, 0, 0); }
        else { sA = __builtin_amdgcn_mfma_f32_32x32x16_bf16(a0, qr[ks], sA, 0, 0, 0); sB = __builtin_amdgcn_mfma_f32_32x32x16_bf16(a1, qr[ks], sB, 0, 0, 0); }
    }
}
constexpr float ATT_THR = 6.f;
__device__ __forceinline__ void attn_unit(LAS unsigned char* lds, const bf16_t* Q, const bf16_t* K, const bf16_t* VT, bf16_t* O, int b, int kvh, int qblk) {
    int tid_ = threadIdx.x; asm volatile("" : "+v"(tid_));
    const int tid = tid_, lane = tid & 63, r32 = lane & 31, hi = lane >> 5; const int wid = __builtin_amdgcn_readfirstlane(tid >> 6);
    const int h = 4 * kvh + (wid >> 1); const int s0 = 64 * qblk + 32 * (wid & 1);
    const size_t qoff = (size_t)(b * S_ + s0 + r32) * 1024 + h * 64;
    bf16x8 qr[4];
#pragma unroll
    for (int ks = 0; ks < 4; ++ks) qr[ks] = *(const bf16x8*)(Q + qoff + 16 * ks + 8 * hi);
    const int lrow = tid >> 3, lch = tid & 7;
    const bf16_t* kg = K + ((size_t)b * SALL + lrow) * 256 + kvh * 64 + lch * 8;
    const bf16_t* vg = VT + ((size_t)(b * 4 + kvh) * 64 + lrow) * SALL + lch * 8;
    LAS unsigned char* kw = lds + lrow * KPITCH + lch * 16;
    LAS unsigned char* vw = lds + 2 * KBUF + lrow * VPITCH + lch * 16;
    u32x4 kreg = *(const u32x4*)kg, vreg = *(const u32x4*)vg, kreg1 = *(const u32x4*)(kg + (size_t)64 * 256);
    __syncthreads();
    *(LAS u32x4*)kw = kreg; *(LAS u32x4*)(kw + KBUF) = kreg1; *(LAS u32x2*)vw = (u32x2){vreg.x, vreg.y}; *(LAS u32x2*)(vw + 8) = (u32x2){vreg.z, vreg.w};
    __syncthreads();
    float l = 0.f; f32x16 o0, o1, negm;
#pragma unroll
    for (int r = 0; r < 16; ++r) { o0[r] = 0.f; o1[r] = 0.f; negm[r] = 0.f; }
    const LAS unsigned char* kr = lds + r32 * KPITCH + hi * 16;
    const LAS unsigned char* vr = lds + 2 * KBUF + r32 * VPITCH + hi * 8;
    constexpr int NT = SALL / 64;
    f32x16 sA, sB, nA, nB;
    attn_qk(sA, sB, kr, qr, negm);
    __syncthreads();
#define ATT_STEP(CA, CB, NA, NB, T) do { \
        const int t_ = (T); const int cur = t_ & 1; \
        if (t_ + 2 < NT) kreg = *(const u32x4*)(kg + (size_t)(t_ + 2) * 64 * 256); \
        if (t_ + 1 < NT) vreg = *(const u32x4*)(vg + (t_ + 1) * 64); \
        if (t_ + 1 < NT) attn_qk(NA, NB, kr + (cur ^ 1) * KBUF, qr, negm); \
        const LAS unsigned char* vb = vr + cur * VBUF; \
        float mx0 = fmaxf(fmaxf(CA[0], CB[0]), CA[1]), mx1 = fmaxf(fmaxf(CB[1], CA[2]), CB[2]); \
        _Pragma("unroll") for (int r = 3; r < 15; r += 2) { mx0 = fmaxf(fmaxf(mx0, CA[r]), CB[r]); mx1 = fmaxf(fmaxf(mx1, CA[r + 1]), CB[r + 1]); } \
        float mx = fmaxf(fmaxf(mx0, mx1), fmaxf(CA[15], CB[15])); \
        mx = fmaxf(mx, __shfl_xor(mx, 32)); \
        if (t_ == 0 || __any(mx > ATT_THR)) { \
            const float dl = (t_ == 0) ? mx : fmaxf(mx, 0.f); \
            const float alpha = __builtin_amdgcn_exp2f(-dl); \
            l *= alpha; \
            _Pragma("unroll") for (int r = 0; r < 16; ++r) { CA[r] -= dl; CB[r] -= dl; o0[r] *= alpha; o1[r] *= alpha; negm[r] -= dl; NA[r] -= dl; NB[r] -= dl; } \
        } \
        float ps0 = 0.f, ps1 = 0.f; \
        _Pragma("unroll") for (int r = 0; r < 16; ++r) { CA[r] = __builtin_amdgcn_exp2f(CA[r]); CB[r] = __builtin_amdgcn_exp2f(CB[r]); ps0 += CA[r]; ps1 += CB[r]; } \
        l += ps0 + ps1; \
        bf16x8 pb[4]; \
        { u32x4 w; \
          w.x = cvt_pk_bf16(CA[0], CA[1]); w.y = cvt_pk_bf16(CA[2], CA[3]); w.z = cvt_pk_bf16(CA[4], CA[5]); w.w = cvt_pk_bf16(CA[6], CA[7]); pb[0] = __builtin_bit_cast(bf16x8, w); \
          w.x = cvt_pk_bf16(CA[8], CA[9]); w.y = cvt_pk_bf16(CA[10], CA[11]); w.z = cvt_pk_bf16(CA[12], CA[13]); w.w = cvt_pk_bf16(CA[14], CA[15]); pb[1] = __builtin_bit_cast(bf16x8, w); \
          w.x = cvt_pk_bf16(CB[0], CB[1]); w.y = cvt_pk_bf16(CB[2], CB[3]); w.z = cvt_pk_bf16(CB[4], CB[5]); w.w = cvt_pk_bf16(CB[6], CB[7]); pb[2] = __builtin_bit_cast(bf16x8, w); \
          w.x = cvt_pk_bf16(CB[8], CB[9]); w.y = cvt_pk_bf16(CB[10], CB[11]); w.z = cvt_pk_bf16(CB[12], CB[13]); w.w = cvt_pk_bf16(CB[14], CB[15]); pb[3] = __builtin_bit_cast(bf16x8, w); } \
        _Pragma("unroll") for (int ks = 0; ks < 4; ++ks) { \
            const int kvb = (32 * (ks >> 1) + 16 * (ks & 1)) * 2; \
            const s16x4 lo0 = *(const LAS s16x4*)(vb + kvb), hi0 = *(const LAS s16x4*)(vb + kvb + 16); \
            const s16x4 lo1 = *(const LAS s16x4*)(vb + 32 * VPITCH + kvb), hi1 = *(const LAS s16x4*)(vb + 32 * VPITCH + kvb + 16); \
            const bf16x8 a0 = {lo0[0], lo0[1], lo0[2], lo0[3], hi0[0], hi0[1], hi0[2], hi0[3]}; \
            const bf16x8 a1 = {lo1[0], lo1[1], lo1[2], lo1[3], hi1[0], hi1[1], hi1[2], hi1[3]}; \
            o0 = __builtin_amdgcn_mfma_f32_32x32x16_bf16(a0, pb[ks], o0, 0, 0, 0); \
            o1 = __builtin_amdgcn_mfma_f32_32x32x16_bf16(a1, pb[ks], o1, 0, 0, 0); \
        } \
        if (t_ + 2 < NT) *(LAS u32x4*)(kw + cur * KBUF) = kreg; \
        if (t_ + 1 < NT) { const int nb = cur ^ 1; *(LAS u32x2*)(vw + nb * VBUF) = (u32x2){vreg.x, vreg.y}; *(LAS u32x2*)(vw + nb * VBUF + 8) = (u32x2){vreg.z, vreg.w}; } \
        __syncthreads(); \
    } while (0)
    static_assert(NT % 2 == 0, "two tile steps per loop trip");
    for (int t = 0; t < NT; t += 2) {
        ATT_STEP(sA, sB, nA, nB, t);
        ATT_STEP(nA, nB, sA, sB, t + 1);
    }
#undef ATT_STEP
    l += __shfl_xor(l, 32);
    const float inv = 1.f / l;
    bf16_t* op = O + qoff + 4 * hi;
#pragma unroll
    for (int g = 0; g < 4; ++g) {
        u32x2 w0, w1;
        w0.x = cvt_pk_bf16(o0[4 * g] * inv, o0[4 * g + 1] * inv); w0.y = cvt_pk_bf16(o0[4 * g + 2] * inv, o0[4 * g + 3] * inv);
        w1.x = cvt_pk_bf16(o1[4 * g] * inv, o1[4 * g + 1] * inv); w1.y = cvt_pk_bf16(o1[4 * g + 2] * inv, o1[4 * g + 3] * inv);
        *(u32x2*)(op + 8 * g) = w0; *(u32x2*)(op + 32 + 8 * g) = w1;
    }
}

__device__ __forceinline__ void transpose_item(const float* W, int K, int Nsrc, bf16_t* WT, int dst_row0, int src_col0, int k0, LAS float* scr, int lane, int dk = 0) {
    f32x4 tv[8];
#pragma unroll
    for (int i = 0; i < 8; ++i) tv[i] = *(const f32x4*)(W + (size_t)(k0 + 8 * i + (lane >> 3)) * Nsrc + src_col0 + 4 * (lane & 7));
#pragma unroll
    for (int i = 0; i < 8; ++i) { LAS float* d = scr + (8 * i + (lane >> 3)) * 33 + 4 * (lane & 7); d[0] = tv[i][0]; d[1] = tv[i][1]; d[2] = tv[i][2]; d[3] = tv[i][3]; }
    asm volatile("s_waitcnt lgkmcnt(0)" ::: "memory");
    const int c = lane & 7;
#pragma unroll
    for (int j = 0; j < 4; ++j) { const int n = (lane >> 3) + 8 * j; const LAS float* s = scr + (8 * c) * 33 + n;
        u32x4 o; o.x = cvt_pk_bf16(s[0 * 33], s[1 * 33]); o.y = cvt_pk_bf16(s[2 * 33], s[3 * 33]); o.z = cvt_pk_bf16(s[4 * 33], s[5 * 33]); o.w = cvt_pk_bf16(s[6 * 33], s[7 * 33]);
        *(u32x4*)(WT + (size_t)(dst_row0 + n) * K + dk + k0 + 8 * c) = o; }
    asm volatile("s_waitcnt lgkmcnt(0)" ::: "memory");
}

__device__ __forceinline__ void phase0(const Params& p, LAS unsigned char* lds) {
    const int tid = threadIdx.x, lane = tid & 63; const int wave = __builtin_amdgcn_readfirstlane(tid >> 6);
    const int G = gridDim.x; const int gw = blockIdx.x * 8 + wave, NGW = G * 8;
    unsigned char* ws = p.ws;
    LAS float* scr = (LAS float*)(lds + wave * 16384);
    LAS float* wbuf = (LAS float*)(lds + wave * 16384 + 8448);
    LAS f32x2v* tw = (LAS f32x2v*)(lds + wave * 16384 + 8448 + 4096);
    {
        const float* wada = p.in[4]; float* PART = (float*)(ws + WS_PART); int ndone = 0;
        for (int it = NGW - 1 - gw; it < 16 * 96; it += NGW) {
            const int kc = it / 96, nb = it % 96; const int n = nb * 64 + lane;
            float sv[9];
#pragma unroll
            for (int r = 0; r < 9; ++r) { const float* cp = r < 8 ? p.in[1] + r * 1024 : p.in[3]; const float v = cp[kc * 64 + lane]; sv[r] = v * sigmoid_(v); }
            float a[9];
#pragma unroll
            for (int r = 0; r < 9; ++r) a[r] = 0.f;
#pragma unroll
            for (int kk = 0; kk < 64; ++kk) { const float w = wada[(size_t)(kc * 64 + kk) * 6144 + n];
#pragma unroll
                for (int r = 0; r < 9; ++r) a[r] += __uint_as_float(__builtin_amdgcn_readlane(__float_as_uint(sv[r]), kk)) * w; }
#pragma unroll
            for (int r = 0; r < 9; ++r) __hip_atomic_store(PART + ((size_t)kc * 9 + r) * 6144 + n, a[r], __ATOMIC_RELAXED, __HIP_MEMORY_SCOPE_AGENT);
            ++ndone;
        }
        asm volatile("s_waitcnt vmcnt(0)" ::: "memory");
        if (lane == 0 && ndone) __hip_atomic_fetch_add((unsigned*)ws + 8192, (unsigned)ndone, __ATOMIC_RELAXED, __HIP_MEMORY_SCOPE_AGENT);
    }
    constexpr int I_IN = 16 * 112, I_AP = 16 * 32, I_FP = 2 * 8 * 32, I_O = 16 * 32, I_GU = 16 * 176;
    constexpr int NT_ITEMS = I_IN + I_AP + I_FP + I_O + I_GU;
    for (int it = gw; it < NT_ITEMS; it += NGW) {
        int r = it;
        if (r < I_IN) { const int kb = r / 112; int gi = r % 112; if (gi >= 48) gi += 32;
            const int pn = gi >> 3, sub = gi & 7, bj = sub >> 2, wc = sub & 3; int src;
            if (pn < 4) src = 64 * (4 * pn + wc) + 32 * bj; else if (pn == 4) src = 1024 + 64 * wc + 32 * bj; else if (pn == 5) src = 1280 + 32 * sub; else src = 2048 + 256 * (pn - 10) + 32 * sub;
            transpose_item(p.in[8], 1024, INW, (bf16_t*)(ws + WS_WIN), 32 * gi, src, 64 * kb, scr, lane); continue; }
        r -= I_IN;
        if (r < I_AP) { transpose_item(p.in[12], 1024, 1024, (bf16_t*)(ws + WS_WAP), 32 * (r % 32), 32 * (r % 32), 64 * (r / 32), scr, lane); continue; }
        r -= I_AP;
        if (r < I_FP) { const int hf = r >> 8, rr = r & 255; transpose_item(p.in[13], 1024, 1024, (bf16_t*)(ws + WS_WFP), 32 * (rr % 32), 32 * (rr % 32), 64 * (rr / 32), scr, lane, 512 * hf); continue; }
        r -= I_FP;
        if (r < I_O) { transpose_item(p.in[14], 1024, 1024, (bf16_t*)(ws + WS_WO), 32 * (r % 32), 32 * (r % 32), 64 * (r / 32), scr, lane); continue; }
        r -= I_O;
        { const int kb = r / 176, gi = r % 176; const int pn = gi >> 3, sub = gi & 7, bj = sub >> 2, q32 = sub & 3;
            transpose_item(p.in[15], 1024, NGU, (bf16_t*)(ws + WS_WGU), 32 * gi, (bj ? DFF : 0) + 128 * pn + 32 * q32, 64 * kb, scr, lane); }
    }
    {
        for (int i = lane; i < 128; i += 64) { const float rev = (float)i * (1.f / 128.f); tw[i] = (f32x2v){__builtin_amdgcn_cosf(rev), __builtin_amdgcn_sinf(rev)}; }
        const float* win = p.in[8]; bf16_t* WIN = (bf16_t*)(ws + WS_WIN);
        for (int it = gw; it < 2048; it += NGW) {
            const int g = it & 3, k0 = 4 * ((it >> 2) & 255), cp = lane + 64 * (it >> 10);
            asm volatile("s_waitcnt lgkmcnt(0)" ::: "memory");
#pragma unroll
            for (int i = 0; i < 8; ++i) { const int idx = i * 64 + lane, kk = idx >> 7, cc = idx & 127; wbuf[cc * 4 + kk] = win[(size_t)(k0 + kk) * INW + 1536 + 128 * g + cc]; }
            asm volatile("s_waitcnt lgkmcnt(0)" ::: "memory");
            float aU[4], aV[4];
#pragma unroll
            for (int kk = 0; kk < 4; ++kk) { aU[kk] = 0.f; aV[kk] = 0.f; }
#pragma unroll 4
            for (int cc = 0; cc < 128; ++cc) {
                const f32x4 w0 = *(const LAS f32x4*)(wbuf + cc * 4); const f32x2v cs = tw[(cc * cp) & 127];
#pragma unroll
                for (int kk = 0; kk < 4; ++kk) { aU[kk] += w0[kk] * cs.x; aV[kk] += w0[kk] * cs.y; }
            }
            const float sc = 0.08838834764831845f;
            u32x2 wu, wv;
            wu.x = cvt_pk_bf16(aU[0] * sc, aU[1] * sc); wu.y = cvt_pk_bf16(aU[2] * sc, aU[3] * sc);
            wv.x = cvt_pk_bf16(aV[0] * sc, aV[1] * sc); wv.y = cvt_pk_bf16(aV[2] * sc, aV[3] * sc);
            *(u32x2*)(WIN + (size_t)(1536 + 128 * g + cp) * 1024 + k0) = wu;
            *(u32x2*)(WIN + (size_t)(1536 + 512 + 128 * g + cp) * 1024 + k0) = wv;
        }
    }
    {
        f32x2v* R = (f32x2v*)(ws + WS_ROPE);
        for (int i = blockIdx.x * NTHREADS + tid; i < 2048 * 32; i += G * NTHREADS) {
            const int s = i >> 5, e = i & 31; const float pos = (float)(e < 16 ? (s >> 6) : (s & 63));
            const float invf = __builtin_amdgcn_exp2f(-(float)(e & 15) * (13.287712379549449f / 16.f));
            float rev = pos * invf * 0.15915494309189535f; rev -= floorf(rev);
            R[i] = (f32x2v){__builtin_amdgcn_cosf(rev), __builtin_amdgcn_sinf(rev)};
        }
    }
}

__device__ __forceinline__ void late_wdown(const Params& p, LAS unsigned char* lds, int first) {
    if ((int)blockIdx.x < first) return;
    const int tid = threadIdx.x, lane = tid & 63; const int wave = __builtin_amdgcn_readfirstlane(tid >> 6);
    const int gw = ((int)blockIdx.x - first) * 8 + wave, NGW = ((int)gridDim.x - first) * 8;
    LAS float* scr = (LAS float*)(lds + wave * 16384);
    for (int r = gw; r < 44 * 32; r += NGW) transpose_item(p.in[16], DFF, 1024, (bf16_t*)(p.ws + WS_WDN), 32 * (r % 32), 32 * (r % 32), 64 * (r / 32), scr, lane);
}
__device__ __forceinline__ void late_prologue(const Params& p, int first) {
    if ((int)blockIdx.x < first) return;
    const int tid = threadIdx.x; const int G = gridDim.x - first; const int bx = (int)blockIdx.x - first; unsigned char* ws = p.ws;
    {
        bf16_t* D = (bf16_t*)(ws + WS_D); const float sc = 0.022097086912079608f;
        for (int i = bx * NTHREADS + tid; i < 2 * 2048 * 256; i += G * NTHREADS) {
            const int kh = i >> 19, n = (i >> 8) & 2047, k8 = (i & 255) * 8; float v[8];
#pragma unroll
            for (int j = 0; j < 8; ++j) { const float rev = (float)((n * (k8 + j)) & 2047) * (1.f / 2048.f);
                v[j] = kh == 0 ? __builtin_amdgcn_cosf(rev) * sc : -__builtin_amdgcn_sinf(rev) * sc; }
            u32x4 w; w.x = cvt_pk_bf16(v[0], v[1]); w.y = cvt_pk_bf16(v[2], v[3]); w.z = cvt_pk_bf16(v[4], v[5]); w.w = cvt_pk_bf16(v[6], v[7]);
            *(u32x4*)(D + (size_t)i * 8) = w;
        }
    }
}

__device__ __forceinline__ void phase1(const Params& p, LAS unsigned char* lds) {
    const int tid = threadIdx.x, lane = tid & 63; const int wave = __builtin_amdgcn_readfirstlane(tid >> 6);
    const int G = gridDim.x; unsigned char* ws = p.ws;
    const float* PART = (const float*)(ws + WS_PART); const float* bada = p.in[5];
    float* MOD = (float*)(ws + WS_MOD);
    if (wave == 0) {
        unsigned sp = 0;
        while ((unsigned)__builtin_amdgcn_readfirstlane(__hip_atomic_load((unsigned*)ws + 8192, __ATOMIC_RELAXED, __HIP_MEMORY_SCOPE_AGENT)) < 16u * 96u) { __builtin_amdgcn_s_sleep(2); if (++sp > (1u << 22)) break; }
    }
    asm volatile("s_waitcnt vmcnt(0) lgkmcnt(0)" ::: "memory"); __syncthreads();
    for (int o = blockIdx.x * NTHREADS + tid; o < 9 * 6144; o += G * NTHREADS) {
        const int r = o / 6144, n = o % 6144; float a = bada[n];
#pragma unroll
        for (int kc = 0; kc < 16; ++kc) a += __hip_atomic_load(PART + ((size_t)kc * 9 + r) * 6144 + n, __ATOMIC_RELAXED, __HIP_MEMORY_SCOPE_AGENT);
        MOD[o] = a;
    }
    LAS float* tab = (LAS float*)lds;
    bf16_t* H = (bf16_t*)(ws + WS_H);
    for (int blk = blockIdx.x; blk < MALL / 72; blk += G) {
        const int r0 = blk * 72, r1 = r0 + 71;
        const int m0 = r0 < MTOK ? (r0 >> 11) : 8, m1 = r1 < MTOK ? (r1 >> 11) : 8;
        __syncthreads();
        for (int q = 0; q < (m1 != m0 ? 2 : 1); ++q) {
            const int mrow = q ? m1 : m0;
            for (int k = tid; k < 1024; k += NTHREADS) {
                float a_sh = bada[k], a_sc = bada[1024 + k];
#pragma unroll
                for (int kc = 0; kc < 16; ++kc) { a_sh += __hip_atomic_load(PART + ((size_t)kc * 9 + mrow) * 6144 + k, __ATOMIC_RELAXED, __HIP_MEMORY_SCOPE_AGENT); a_sc += __hip_atomic_load(PART + ((size_t)kc * 9 + mrow) * 6144 + 1024 + k, __ATOMIC_RELAXED, __HIP_MEMORY_SCOPE_AGENT); }
                tab[q * 2048 + k] = p.in[6][k] * (1.f + a_sc); tab[q * 2048 + 1024 + k] = a_sh;
            }
        }
        __syncthreads();
        f32x4 v[9][4];
#pragma unroll
        for (int rr = 0; rr < 9; ++rr) {
            const int row = r0 + wave * 9 + rr;
            const float* src = row < MTOK ? p.in[0] + (size_t)row * 1024 : p.in[2] + (size_t)(row - MTOK) * 1024;
#pragma unroll
            for (int j = 0; j < 4; ++j) v[rr][j] = *(const f32x4*)(src + 4 * lane + 256 * j);
        }
#pragma unroll
        for (int rr = 0; rr < 9; ++rr) {
            const int row = r0 + wave * 9 + rr; const int mr = row < MTOK ? (row >> 11) : 8;
            LAS float* gm = tab + (mr != m0 ? 2048 : 0); LAS float* sh = gm + 1024;
            float s = 0.f;
#pragma unroll
            for (int j = 0; j < 4; ++j) s += (v[rr][j][0] * v[rr][j][0] + v[rr][j][1] * v[rr][j][1]) + (v[rr][j][2] * v[rr][j][2] + v[rr][j][3] * v[rr][j][3]);
            const float rs = __builtin_amdgcn_rsqf(wave_sum(s) * (1.f / 1024.f) + EPS);
#pragma unroll
            for (int j = 0; j < 4; ++j) { const int k = 4 * lane + 256 * j; const f32x4 g4 = *(const LAS f32x4*)(gm + k), s4 = *(const LAS f32x4*)(sh + k);
                const f32x4 o = v[rr][j] * rs * g4 + s4; u32x2 w; w.x = cvt_pk_bf16(o[0], o[1]); w.y = cvt_pk_bf16(o[2], o[3]);
                *(u32x2*)(H + (size_t)row * 1024 + k) = w; }
        }
    }
}

__device__ __forceinline__ void bias2_phase(const Params& p, LAS unsigned char* lds, int first) {
    const int tid = threadIdx.x, lane = tid & 63; const int wave = __builtin_amdgcn_readfirstlane(tid >> 6);
    const int G = gridDim.x; unsigned char* ws = p.ws;
    const float* MOD = (const float*)(ws + WS_MOD); const bf16_t* WGU = (const bf16_t*)(ws + WS_WGU); float* B2 = (float*)(ws + WS_BIAS2);
    f32x4 sh[4];
#pragma unroll
    for (int q = 0; q < 4; ++q) sh[q] = *(const f32x4*)(MOD + wave * 6144 + 3 * 1024 + 16 * lane + 4 * q);
    if ((int)blockIdx.x < first) return;
    const int nblk = G - first; const int rows_per = (NGU + nblk - 1) / nblk;
    const int rbeg = ((int)blockIdx.x - first) * rows_per, rend = (rbeg + rows_per < NGU) ? rbeg + rows_per : NGU;
    for (int r0 = rbeg; r0 < rend; r0 += 11) {
        u32x4 w0[11], w1[11];
#pragma unroll
        for (int r = 0; r < 11; ++r) { const int row = (r0 + r < rend) ? r0 + r : r0;
            w0[r] = *(const u32x4*)(WGU + (size_t)row * 1024 + 16 * lane); w1[r] = *(const u32x4*)(WGU + (size_t)row * 1024 + 16 * lane + 8); }
        float part[11];
#pragma unroll
        for (int r = 0; r < 11; ++r) {
            const f32x4 f0 = {bf_lo(w0[r].x), bf_hi(w0[r].x), bf_lo(w0[r].y), bf_hi(w0[r].y)}, f1 = {bf_lo(w0[r].z), bf_hi(w0[r].z), bf_lo(w0[r].w), bf_hi(w0[r].w)};
            const f32x4 f2 = {bf_lo(w1[r].x), bf_hi(w1[r].x), bf_lo(w1[r].y), bf_hi(w1[r].y)}, f3 = {bf_lo(w1[r].z), bf_hi(w1[r].z), bf_lo(w1[r].w), bf_hi(w1[r].w)};
            const f32x4 a4 = f0 * sh[0] + f1 * sh[1] + f2 * sh[2] + f3 * sh[3]; part[r] = (a4[0] + a4[1]) + (a4[2] + a4[3]);
        }
#pragma unroll
        for (int o = 1; o < 64; o <<= 1)
#pragma unroll
            for (int r = 0; r < 11; ++r) part[r] += __shfl_xor(part[r], o);
        if (lane == 0) {
#pragma unroll
            for (int r = 0; r < 11; ++r) { const int row = r0 + r;
                if (row < rend) { const int rem = row & 255; const int cidx = (rem < 128 ? 0 : DFF) + 128 * (row >> 8) + (rem & 127); B2[wave * NGU + cidx] = part[r]; } }
        }
    }
}

__device__ __forceinline__ void phase_final(const Params& p) {
    const int tid = threadIdx.x, lane = tid & 63; const int wave = __builtin_amdgcn_readfirstlane(tid >> 6);
    const int gw = blockIdx.x * 8 + wave, NGW = gridDim.x * 8;
    const float* SS = (const float*)(p.ws + WS_SS2); const float* gf = p.in[17]; float* out = p.out;
    f32x4 g4[4];
#pragma unroll
    for (int j = 0; j < 4; ++j) g4[j] = *(const f32x4*)(gf + 4 * lane + 256 * j);
    for (int row = gw; row < MTOK; row += NGW) {
        const f32x4* sp = (const f32x4*)(SS + (size_t)row * 16);
        const f32x4 s4 = (sp[0] + sp[1]) + (sp[2] + sp[3]);
        const float rs = __builtin_amdgcn_rsqf(((s4[0] + s4[1]) + (s4[2] + s4[3])) * (1.f / 1024.f) + EPS);
#pragma unroll
        for (int j = 0; j < 4; ++j) { f32x4* q = (f32x4*)(out + (size_t)row * 1024 + 4 * lane + 256 * j); *q = *q * rs * g4[j]; }
    }
}


#ifndef DBG_STOP
#define DBG_STOP 0
#endif
#ifndef REP_PH
#define REP_PH -1
#endif
#define NREP(k) ((REP_PH == (k)) ? 2 : 1)
__device__ __forceinline__ float bfv(const bf16_t* p, size_t i) { return __uint_as_float((unsigned)p[i] << 16); }
__device__ __forceinline__ void dbg_dump(const Params& p, int which) {
    unsigned char* ws = p.ws; const size_t N = (size_t)MTOK * 1024;
    for (size_t i = (size_t)blockIdx.x * NTHREADS + threadIdx.x; i < N; i += (size_t)gridDim.x * NTHREADS) {
        float v = 0.f;
        if (which == 2) v = bfv((const bf16_t*)(ws + WS_Q), i) + bfv((const bf16_t*)(ws + WS_G), 2 * i) + bfv((const bf16_t*)(ws + WS_G), 2 * i + 1) + bfv((const bf16_t*)(ws + WS_UVT), i)
                          + bfv((const bf16_t*)(ws + WS_K), i % 4718592) + bfv((const bf16_t*)(ws + WS_VT), i % 4718592);
        else if (which == 3) v = bfv((const bf16_t*)(ws + WS_Q), i) + bfv((const bf16_t*)(ws + WS_Y), i);
        else if (which == 4) v = bfv((const bf16_t*)(ws + WS_MG), i);
        else if (which == 5) v = p.out[i] + bfv((const bf16_t*)(ws + WS_A2), i);
        else if (which == 1) v = bfv((const bf16_t*)(ws + WS_H), i) + bfv((const bf16_t*)(ws + WS_WIN), i % 4718592) + bfv((const bf16_t*)(ws + WS_D), i % 8388608) + bfv((const bf16_t*)(ws + WS_WGU), i % 5767168);
        p.out[i] = v;
    }
}
#define DBG_AT(k) do { if (DBG_STOP == (k)) { dbg_dump(p, (k)); return; } } while (0)
#define XB_TMO      128
#define XB_XCNT(j)  (256  + 64 * (j))
#define XB_XSUB(j)  (1280 + 64 * (j))
#define XB_XGEN(j)  (2304 + 64 * (j))
#define XB_TOP      3328
#define XB_TOPGEN   3392
#define XCD_BAR_WORDS 3456
#define XB_SPIN_CAP (1u << 18)

__device__ __forceinline__ unsigned xb_ld(unsigned* p)              { return __hip_atomic_load(p, __ATOMIC_RELAXED, __HIP_MEMORY_SCOPE_AGENT); }
__device__ __forceinline__ unsigned xb_add(unsigned* p, unsigned v) { return __hip_atomic_fetch_add(p, v, __ATOMIC_RELAXED, __HIP_MEMORY_SCOPE_AGENT); }
__device__ __forceinline__ unsigned xb_xcc_id() { return (unsigned)__builtin_amdgcn_s_getreg((3 << 11) | 20) & 0xFu; }
#define XB_SPIN(cond, bar) do { unsigned _sp = 0; while (cond) { __builtin_amdgcn_s_sleep(4); \
    if ((++_sp & 255u) == 0u) { if (xb_ld(&(bar)[XB_TMO])) break; if (_sp > XB_SPIN_CAP) { atomicAdd(&(bar)[XB_TMO], 1u); break; } } } } while (0)

struct XcdBarrier {
    unsigned* bar; unsigned x;
    volatile LAS unsigned* st;
};

__device__ __forceinline__ XcdBarrier xcd_barrier_post(unsigned* bar, volatile LAS unsigned* st) {
    XcdBarrier b; b.bar = bar; b.x = xb_xcc_id(); b.st = st;
    if (threadIdx.x == 0) (void)xb_add(&bar[XB_XCNT(b.x)], 1u);
    return b;
}
__device__ __forceinline__ void xcd_barrier_complete(unsigned* bar, unsigned x, unsigned& nloc, unsigned& nx) {
    const unsigned G = gridDim.x * gridDim.y * gridDim.z;
    unsigned sum, cnt, mine, sp = 0u;
    for (;;) {
        sum = 0u; cnt = 0u; mine = 0u;
#pragma unroll
        for (unsigned j = 0; j < 16; ++j) { const unsigned c = xb_ld(&bar[XB_XCNT(j)]); sum += c; cnt += (c > 0u) ? 1u : 0u; mine = (j == x) ? c : mine; }
        if (sum == G) break;
        __builtin_amdgcn_s_sleep(1);
        if ((++sp & 255u) == 0u) { if (xb_ld(&bar[XB_TMO])) break; if (sp > XB_SPIN_CAP) { atomicAdd(&bar[XB_TMO], 1u); break; } }
    }
    nloc = mine > 0u ? mine : 1u; nx = cnt > 0u ? cnt : 1u;
}

__device__ __forceinline__ void xcd_barrier(const XcdBarrier& b) {
    asm volatile("s_waitcnt vmcnt(0)" ::: "memory");
    __syncthreads();
    if (threadIdx.x == 0) {
        unsigned* bar = b.bar;
        __builtin_amdgcn_s_waitcnt(0);
        unsigned nloc = b.st[0], nx = b.st[1];
        if (nloc == 0u) { xcd_barrier_complete(bar, b.x, nloc, nx); b.st[0] = nloc; b.st[1] = nx; }
        const unsigned old = xb_add(&bar[XB_XSUB(b.x)], 1u);
        const unsigned gen = old / nloc;
        if (old + 1u == (gen + 1u) * nloc) {
            __builtin_amdgcn_fence(__ATOMIC_RELEASE, "agent");
            asm volatile("s_waitcnt vmcnt(0)" ::: "memory");
            const unsigned og = xb_add(&bar[XB_TOP], 1u);
            const unsigned tg = og / nx;
            if (og + 1u == (tg + 1u) * nx) xb_add(&bar[XB_TOPGEN], 1u);
            else XB_SPIN(xb_ld(&bar[XB_TOPGEN]) == tg, bar);
            __builtin_amdgcn_fence(__ATOMIC_ACQUIRE, "agent");
            xb_add(&bar[XB_XGEN(b.x)], 1u);
            asm volatile("s_waitcnt vmcnt(0)" ::: "memory");
        } else {
            XB_SPIN(xb_ld(&bar[XB_XGEN(b.x)]) == gen, bar);
            __builtin_amdgcn_fence(__ATOMIC_ACQUIRE, "agent");
            asm volatile("s_waitcnt vmcnt(0)" ::: "memory");
        }
    }
    __syncthreads();
}

__global__ void __launch_bounds__(NTHREADS, 2) fwd_megakernel(Params p) {
    extern __shared__ __attribute__((aligned(16))) unsigned char lds_raw[];
    LAS unsigned char* lds = (LAS unsigned char*)lds_raw;
    cg::grid_group grid = cg::this_grid();
    if (gridDim.x == 0x7fffffffu) grid.sync();
    volatile LAS unsigned* bar_st = (volatile LAS unsigned*)(lds + 131072);
    if (threadIdx.x < 2) bar_st[threadIdx.x] = 0u;
    __syncthreads();
    const XcdBarrier xbar = xcd_barrier_post((unsigned*)p.ws, bar_st);
#define GRID_SYNC() xcd_barrier(xbar)
    unsigned char* ws = p.ws;
    const int G = gridDim.x, c = blockIdx.x;

    for (int rep = 0; rep < NREP(0); ++rep) { phase0(p, lds); __syncthreads(); }
    for (int rep = 0; rep < NREP(1); ++rep) { phase1(p, lds); __syncthreads(); }
    GRID_SYNC();
    DBG_AT(1);
    for (int rep = 0; rep < NREP(2); ++rep) {
        pg8::Gemm g{(const bf16_t*)(ws + WS_H), (const bf16_t*)(ws + WS_WIN), MALL, NIN, 1024};
        SchedIn Sd; Sd.init(G, c);
        EpiIn E{(bf16_t*)(ws + WS_Q), (bf16_t*)(ws + WS_K), (bf16_t*)(ws + WS_VT), (bf16_t*)(ws + WS_UVT), (bf16_t*)(ws + WS_G), p.in[10], p.in[11], p.in[9], (const f32x2v*)(ws + WS_ROPE)};
        pg8::gemm_phase<EpiIn, SchedIn, true, true>(lds, g, Sd, E);
        bias2_phase(p, lds, G == 256 ? 144 : 0);
        late_prologue(p, G == 256 ? 144 : 0);
    }
    GRID_SYNC();
    DBG_AT(2);
    {
        const bf16_t* Q = (const bf16_t*)(ws + WS_Q);
        for (int rep = 0; rep < NREP(3); ++rep) {
        bf16_t* Odst = (rep + 1 < NREP(3)) ? (bf16_t*)p.out : (bf16_t*)(ws + WS_Q);
        for (int i = 0;; ++i) {
            const long L = (long)i * G + c; if (L >= 1024) break;
            int pair, qblk;
            if (G == 256) { pair = (c & 7) * 4 + i; qblk = c >> 3; } else { pair = (int)(L >> 5); qblk = (int)(L & 31); }
            attn_unit(lds, Q, (const bf16_t*)(ws + WS_K), (const bf16_t*)(ws + WS_VT), Odst, pair >> 2, pair & 3, qblk);
        }
        __syncthreads();
        }
        pg8::Gemm g{(const bf16_t*)(ws + WS_D), (const bf16_t*)(ws + WS_UVT), 4096, 16384, 2048};
        SchedFour Sd{G, c};
        EpiY E{(bf16_t*)(ws + WS_Y)};
        for (int rep = 0; rep < NREP(9); ++rep) pg8::gemm_phase<EpiY, SchedFour, true, true>(lds, g, Sd, E);
    }
    GRID_SYNC();
    DBG_AT(3);
    for (int rep = 0; rep < NREP(4); ++rep) {
        pg8::StaticOrder Sd; Sd.init(MTOK, 1024, G, c);
        pg8::Gemm g{(const bf16_t*)(ws + WS_Y), (const bf16_t*)(ws + WS_WAP), MTOK, 1024, 1024};
        SchedMerge Sm{Sd};
        EpiMerge E{EpiGateF{(const bf16_t*)(ws + WS_G), (bf16_t*)(ws + WS_MG)}, EpiGateA{(const bf16_t*)(ws + WS_G), (bf16_t*)(ws + WS_MG)}};
        pg8::gemm_phase<EpiMerge, SchedMerge, true, true>(lds, g, Sm, E);
    }
    GRID_SYNC();
    DBG_AT(4);
    for (int rep = 0; rep < NREP(5); ++rep) {
        pg8::StaticOrder Sd; Sd.init(MTOK, 1024, G, c);
        pg8::Gemm g{(const bf16_t*)(ws + WS_MG), (const bf16_t*)(ws + WS_WO), MTOK, 1024, 1024};
        EpiWo E{p.in[0], (const float*)(ws + WS_MOD), p.in[7], p.out, (bf16_t*)(ws + WS_A2), (float*)(ws + WS_SS1)};
        pg8::gemm_phase<EpiWo, pg8::StaticOrder, true, true>(lds, g, Sd, E);
    }
    GRID_SYNC();
    DBG_AT(5);
    for (int rep = 0; rep < NREP(6); ++rep) {
        pg8::StaticOrder Sd; Sd.init(MTOK, NGU, G, c);
        pg8::Gemm g{(const bf16_t*)(ws + WS_A2), (const bf16_t*)(ws + WS_WGU), MTOK, NGU, 1024};
        EpiGU E{(const float*)(ws + WS_SS1), (const float*)(ws + WS_BIAS2), (bf16_t*)(ws + WS_ACT)};
        pg8::gemm_phase<EpiGU, pg8::StaticOrder, true, true>(lds, g, Sd, E);
        late_wdown(p, lds, G == 256 ? 128 : 0);
    }
    GRID_SYNC();
    if (G == 256) {
        pg8::StaticOrder Sd; Sd.init(MTOK, 1024, G, c);
        pg8::Gemm g{(const bf16_t*)(ws + WS_ACT), (const bf16_t*)(ws + WS_WDN), MTOK, 1024, DFF};
        EpiDownFused E{(const float*)(ws + WS_MOD), p.out, (float*)(ws + WS_SS2), (unsigned*)ws + 4096, p.in[17]};
        if (REP_PH == 7) { EpiNull E0{(float*)(ws + WS_SS2)}; pg8::gemm_phase<EpiNull, pg8::StaticOrder, true, true>(lds, g, Sd, E0); }
        pg8::gemm_phase<EpiDownFused, pg8::StaticOrder, false, true>(lds, g, Sd, E);
        return;
    }
    {
        pg8::StaticOrder Sd; Sd.init(MTOK, 1024, G, c);
        pg8::Gemm g{(const bf16_t*)(ws + WS_ACT), (const bf16_t*)(ws + WS_WDN), MTOK, 1024, DFF};
        EpiDown E{(const float*)(ws + WS_MOD), p.out, (float*)(ws + WS_SS2)};
        pg8::gemm_phase<EpiDown, pg8::StaticOrder, true, true>(lds, g, Sd, E);
    }
    GRID_SYNC();
    if (REP_PH == 8) { for (int rep = 0; rep < 8; ++rep) GRID_SYNC(); }
    phase_final(p);
}

extern "C" void kernel_launch(void* const* d_in, const int* in_sizes, int n_in, void* d_out, int out_size, void* d_ws, size_t ws_size, hipStream_t stream) {
    static int grid_blocks = 0;
    if (grid_blocks == 0) {
        if (n_in != 18 || out_size != MTOK * DM || ws_size < WS_END) { fprintf(stderr, "kernel_launch: unexpected shapes (n_in %d out %d ws %zu)\n", n_in, out_size, ws_size); grid_blocks = -1; return; }
        int dev = 0, cus = 0, per_cu = 0;
        hipGetDevice(&dev);
        hipDeviceGetAttribute(&cus, hipDeviceAttributeMultiprocessorCount, dev);
        hipFuncSetAttribute((const void*)fwd_megakernel, hipFuncAttributeMaxDynamicSharedMemorySize, LDS_BYTES);
        hipOccupancyMaxActiveBlocksPerMultiprocessor(&per_cu, (const void*)fwd_megakernel, NTHREADS, LDS_BYTES);
        if (per_cu < 1) { fprintf(stderr, "kernel_launch: occupancy query says %d blocks per CU\n", per_cu); per_cu = 1; }
        if (per_cu > 1) per_cu = 1;
        grid_blocks = cus * per_cu;
    }
    if (grid_blocks < 0) return;
    Params p{};
    for (int i = 0; i < 18; ++i) p.in[i] = (const float*)d_in[i];
    p.out = (float*)d_out; p.ws = (unsigned char*)d_ws;
    if (hipMemsetAsync(d_ws, 0, 65536, stream) != hipSuccess) { fprintf(stderr, "kernel_launch: memset of the barrier words failed\n"); return; }
    void* args[] = {&p};
    hipError_t e = hipLaunchCooperativeKernel((const void*)fwd_megakernel, dim3(grid_blocks), dim3(NTHREADS), args, LDS_BYTES, stream);
    if (e != hipSuccess) fprintf(stderr, "cooperative launch failed: %s (grid %d)\n", hipGetErrorString(e), grid_blocks);
}
```

```cpp
#include <hip/hip_runtime.h>
#include <hip/hip_cooperative_groups.h>
#include <cstdio>
#include <cstdint>
namespace cg = cooperative_groups;
namespace pg8 {
#define PG8_LAS __attribute__((address_space(3)))
typedef unsigned short bf16_t;
typedef short bf16x8 __attribute__((ext_vector_type(8)));
typedef float f32x4 __attribute__((ext_vector_type(4)));
typedef unsigned u32x4 __attribute__((ext_vector_type(4)));
constexpr int BM = 256, BK = 64, HALF = 128, HTB = HALF * BK * 2  , STAGE_BYTES = 8 * HTB, NXCD = 8, WGM = 8;

__host__ __device__ __forceinline__ int lds_byte(int r, int c) { const int st = (r >> 4) * 2 + (c >> 5), rr = r & 15, cc = c & 31, ob = rr * 64 + cc * 2; return st * 1024 + (ob ^ (((ob >> 9) & 1) << 5)); }
__host__ __device__ __forceinline__ void stage_rc(int b, int& R, int& C) { const int st = b / 1024, sb = b % 1024, swz = sb ^ (((sb >> 9) & 1) << 5); R = (st >> 1) * 16 + swz / 64; C = (st & 1) * 32 + (swz % 64) / 2; }
__host__ __device__ __forceinline__ int perm32(int rho) { const int n = rho >> 4, i = rho & 15; return 8 * (i >> 2) + 4 * n + (i & 3); }

struct Unit { int pm, pn; };
struct Gemm { const bf16_t* A; const bf16_t* Bt; int M, N, K; };

struct StaticOrder {
    int nM, nN, nwg, G, c;
    __host__ __device__ void init(int M, int N, int G_, int c_) { nM = M / BM; nN = N / BM; nwg = nM * nN; G = G_; c = c_; }
    __host__ __device__ bool next(int i, Unit& u) const {
        const long L = (long)i * G + c; if (L >= nwg) return false;
        int wgid = (int)L; { const int q = nwg / NXCD, r = nwg % NXCD, xcd = wgid % NXCD, off = wgid / NXCD; wgid = (xcd < r ? xcd * (q + 1) : r * (q + 1) + (xcd - r) * q) + off; }
        const int nig = WGM * nN, gid = wgid / nig, fm = gid * WGM, gsz = (nM - fm) < WGM ? (nM - fm) : WGM;
        u.pm = fm + ((wgid % nig) % gsz); u.pn = (wgid % nig) / gsz; return true;
    }
    __device__ __forceinline__ void a_ready(const Unit&) const {}
    __device__ __forceinline__ void done(const Unit&) const {}
};

typedef float f32x2_t __attribute__((ext_vector_type(2))); typedef __bf16 bf16x2_t __attribute__((ext_vector_type(2)));
__device__ __forceinline__ unsigned cvt_pk_bf16(float lo, float hi) { f32x2_t v = {lo, hi}; bf16x2_t b = __builtin_convertvector(v, bf16x2_t); return __builtin_bit_cast(unsigned, b); }
template <class Epi, class Sched, bool ALIGN_EPI = false, bool SP2 = false>
__device__ __forceinline__ void gemm_phase(PG8_LAS unsigned char* lds, const Gemm g, const Sched& S, const Epi& E) {
    int tid_ = threadIdx.x; asm volatile("" : "+v"(tid_));
    const int tid = tid_, wid = __builtin_amdgcn_readfirstlane(tid >> 6), lane = tid & 63, wr = wid >> 2, wc = wid & 3, fr = lane & 15, fq = lane >> 4;
    const int K = g.K, nt = K / BK;
    unsigned voffA[2], voffB[2];
#pragma unroll
    for (int i = 0; i < 2; ++i) { int R, C; stage_rc(tid * 16 + i * 8192, R, C); const int Rb = Epi::PERM ? ((R & ~31) + perm32(R & 31)) : R;
        voffA[i] = (unsigned)(R * K + C) * 2u; voffB[i] = (unsigned)(Rb * K + C) * 2u; }
    const size_t kstep = (size_t)(BK * 2);
    const size_t hstep = (size_t)HALF * K * 2;
    const size_t tstep = 2 * hstep;
    const unsigned ldsw = (unsigned)wid * 1024u;
    const int aoff = lds_byte(wr * 64 + fr, fq * 8), boff = lds_byte(wc * 32 + fr, fq * 8);
#define PG8_SA(b, h) (((b) * 2 + (h)) * HTB)
#define PG8_SB(b, h) ((4 + (b) * 2 + (h)) * HTB)
#define PG8_STAGE(bufoff, gbase, voff) do { _Pragma("unroll") for (int _i = 0; _i < 2; ++_i) \
        __builtin_amdgcn_global_load_lds((const unsigned*)((const char*)(gbase) + (voff)[_i]), (PG8_LAS unsigned*)(lds + (bufoff) + ldsw + _i * 8192), 16, 0, 0); } while (0)
#define PG8_LDA(dst, b, h) do { _Pragma("unroll") for (int m = 0; m < 4; ++m) _Pragma("unroll") for (int k = 0; k < 2; ++k) dst[m][k] = *(const PG8_LAS bf16x8*)(lds + PG8_SA(b, h) + aoff + m * 2048 + k * 1024); } while (0)
#define PG8_LDB(dst, b, h) do { _Pragma("unroll") for (int n = 0; n < 2; ++n) _Pragma("unroll") for (int k = 0; k < 2; ++k) dst[n][k] = *(const PG8_LAS bf16x8*)(lds + PG8_SB(b, h) + boff + n * 2048 + k * 1024); } while (0)
#define PG8_MMA(ai, bj, At, Bt) do { __builtin_amdgcn_s_setprio(1); _Pragma("unroll") for (int m = 0; m < 4; ++m) _Pragma("unroll") for (int n = 0; n < 2; ++n) _Pragma("unroll") for (int k = 0; k < 2; ++k) \
        acc[ai][bj][m][n] = __builtin_amdgcn_mfma_f32_16x16x32_bf16(Bt[n][k], At[m][k], acc[ai][bj][m][n], 0, 0, 0); __builtin_amdgcn_s_setprio(0); } while (0)
#define PG8_WAIT_V(n) asm volatile("s_waitcnt vmcnt(" #n ")" ::: "memory")
#define PG8_WAIT_L(n) asm volatile("s_waitcnt lgkmcnt(" #n ")" ::: "memory")
#define PG8_BAR __builtin_amdgcn_s_barrier()
#define PG8_SCHED __builtin_amdgcn_sched_barrier(0)
    Unit cur, nxt; int ui = 0;
    if (!S.next(0, cur)) return;
    f32x4 acc[2][2][4][2];
#pragma unroll
    for (int a = 0; a < 2; ++a)
#pragma unroll
        for (int b = 0; b < 2; ++b)
#pragma unroll
            for (int m = 0; m < 4; ++m)
#pragma unroll
                for (int n = 0; n < 2; ++n) acc[a][b][m][n] = (f32x4){0.f, 0.f, 0.f, 0.f};
    bf16x8 At[4][2], B0[2][2], B1[2][2];
    const char* cA = (const char*)g.A + (size_t)cur.pm * tstep; const char* cB = (const char*)g.Bt + (size_t)cur.pn * tstep;
    S.a_ready(cur);
    if constexpr (SP2) {
        PG8_STAGE(PG8_SB(0, 0), cB, voffB); PG8_STAGE(PG8_SB(0, 1), cB + hstep, voffB); PG8_STAGE(PG8_SA(0, 0), cA, voffA); PG8_STAGE(PG8_SA(0, 1), cA + hstep, voffA);
        if (wr == 1) PG8_BAR;
        PG8_WAIT_V(2); PG8_BAR;
        PG8_STAGE(PG8_SB(1, 0), cB + kstep, voffB); PG8_STAGE(PG8_SA(1, 0), cA + kstep, voffA); PG8_STAGE(PG8_SB(1, 1), cB + hstep + kstep, voffB);
        PG8_WAIT_V(6); PG8_BAR;
    } else {
        PG8_STAGE(PG8_SB(0, 0), cB, voffB); PG8_STAGE(PG8_SA(0, 0), cA, voffA); PG8_STAGE(PG8_SB(0, 1), cB + hstep, voffB); PG8_STAGE(PG8_SA(0, 1), cA + hstep, voffA);
        if (wr == 1) PG8_BAR;
        PG8_WAIT_V(4); PG8_BAR;
        PG8_STAGE(PG8_SB(1, 0), cB + kstep, voffB); PG8_STAGE(PG8_SA(1, 0), cA + kstep, voffA); PG8_STAGE(PG8_SB(1, 1), cB + hstep + kstep, voffB);
        PG8_WAIT_V(6); PG8_BAR;
    }
    for (;;) {
        const bool has_next = S.next(ui + 1, nxt);
        const char* nA = has_next ? (const char*)g.A + (size_t)nxt.pm * tstep : cA; const char* nB = has_next ? (const char*)g.Bt + (size_t)nxt.pn * tstep : cB;
        for (int t = 0; t < nt; t += 2) {
            const bool last = (t == nt - 2);
            const char* a1 = cA + (size_t)(t + 1) * kstep;
            const char* a2 = last ? nA : cA + (size_t)(t + 2) * kstep; const char* b2 = last ? nB : cB + (size_t)(t + 2) * kstep;
            const char* a3 = a2 + kstep; const char* b3 = b2 + kstep;
            if (last && has_next) S.a_ready(nxt);
            if constexpr (SP2) {
            PG8_LDB(B0, 0, 0); PG8_LDB(B1, 0, 1); PG8_SCHED; PG8_LDA(At, 0, 0); PG8_STAGE(PG8_SA(1, 1), a1 + hstep, voffA);
            PG8_WAIT_V(8); PG8_WAIT_L(0); PG8_BAR; PG8_MMA(0, 0, At, B0); PG8_MMA(0, 1, At, B1); PG8_BAR; PG8_SCHED;
            PG8_LDA(At, 0, 1); PG8_STAGE(PG8_SB(0, 0), b2, voffB); PG8_STAGE(PG8_SB(0, 1), b2 + hstep, voffB); PG8_STAGE(PG8_SA(0, 0), a2, voffA);
            PG8_WAIT_V(8); PG8_WAIT_L(0); PG8_BAR; PG8_MMA(1, 0, At, B0); PG8_MMA(1, 1, At, B1); PG8_BAR; PG8_SCHED;
            PG8_LDB(B0, 1, 0); PG8_LDB(B1, 1, 1); PG8_SCHED; PG8_LDA(At, 1, 0); PG8_STAGE(PG8_SA(0, 1), a2 + hstep, voffA);
            PG8_WAIT_V(8); PG8_WAIT_L(0); PG8_BAR; PG8_MMA(0, 0, At, B0); PG8_MMA(0, 1, At, B1); PG8_BAR; PG8_SCHED;
            PG8_LDA(At, 1, 1); PG8_STAGE(PG8_SB(1, 0), b3, voffB); PG8_STAGE(PG8_SB(1, 1), b3 + hstep, voffB); PG8_STAGE(PG8_SA(1, 0), a3, voffA);
            PG8_WAIT_V(8); PG8_WAIT_L(0); PG8_BAR; PG8_MMA(1, 0, At, B0); PG8_MMA(1, 1, At, B1); PG8_BAR; PG8_SCHED;
            } else {
            PG8_LDB(B0, 0, 0); PG8_SCHED; PG8_LDA(At, 0, 0); PG8_STAGE(PG8_SA(1, 1), a1 + hstep, voffA);
            PG8_WAIT_L(8); PG8_BAR; PG8_WAIT_L(0); PG8_MMA(0, 0, At, B0); PG8_BAR; PG8_SCHED;
            PG8_LDB(B1, 0, 1); PG8_STAGE(PG8_SB(0, 0), b2, voffB);
            PG8_BAR; PG8_WAIT_L(0); PG8_MMA(0, 1, At, B1); PG8_BAR;
            PG8_LDA(At, 0, 1); PG8_STAGE(PG8_SA(0, 0), a2, voffA);
            PG8_BAR; PG8_WAIT_L(0); PG8_MMA(1, 0, At, B0); PG8_BAR; PG8_SCHED;
            PG8_STAGE(PG8_SB(0, 1), b2 + hstep, voffB);
            PG8_WAIT_V(6); PG8_BAR; PG8_MMA(1, 1, At, B1); PG8_BAR;
            PG8_LDB(B0, 1, 0); PG8_SCHED; PG8_LDA(At, 1, 0); PG8_STAGE(PG8_SA(0, 1), a2 + hstep, voffA);
            PG8_WAIT_L(8); PG8_BAR; PG8_WAIT_L(0); PG8_MMA(0, 0, At, B0); PG8_BAR; PG8_SCHED;
            PG8_LDB(B1, 1, 1); PG8_STAGE(PG8_SB(1, 0), b3, voffB);
            PG8_BAR; PG8_WAIT_L(0); PG8_MMA(0, 1, At, B1); PG8_BAR;
            PG8_LDA(At, 1, 1); PG8_STAGE(PG8_SA(1, 0), a3, voffA);
            PG8_BAR; PG8_WAIT_L(0); PG8_MMA(1, 0, At, B0); PG8_BAR; PG8_SCHED;
            PG8_STAGE(PG8_SB(1, 1), b3 + hstep, voffB);
            PG8_WAIT_V(6); PG8_BAR; PG8_MMA(1, 1, At, B1); PG8_BAR;
            }
        }
        if constexpr (ALIGN_EPI) { if (wr == 0) PG8_BAR; }
        if constexpr (!Epi::AFTER_DRAIN) { E(acc, cur, wr, wc, fr, fq); S.done(cur); }
        if (!has_next) break;
#pragma unroll
        for (int a = 0; a < 2; ++a)
#pragma unroll
            for (int b = 0; b < 2; ++b)
#pragma unroll
                for (int m = 0; m < 4; ++m)
#pragma unroll
                    for (int n = 0; n < 2; ++n) acc[a][b][m][n] = (f32x4){0.f, 0.f, 0.f, 0.f};
        cur = nxt; cA = nA; cB = nB; ++ui;
        if constexpr (ALIGN_EPI) { if (wr == 1) PG8_BAR; }
    }
    PG8_WAIT_V(0);
    if constexpr (!ALIGN_EPI) { if (wr == 0) PG8_BAR; }
    PG8_BAR;
    if constexpr (Epi::AFTER_DRAIN) { E.fused(acc, cur, wr, wc, fr, fq, lds, wid, lane); S.done(cur); }
#undef PG8_SA
#undef PG8_SB
#undef PG8_STAGE
#undef PG8_LDA
#undef PG8_LDB
#undef PG8_MMA
#undef PG8_WAIT_V
#undef PG8_WAIT_L
#undef PG8_BAR
#undef PG8_SCHED
}
}

using pg8::bf16_t; using pg8::f32x4; using pg8::u32x4; using pg8::bf16x8; using pg8::Unit; using pg8::cvt_pk_bf16;
#define LAS __attribute__((address_space(3)))
typedef float f32x16 __attribute__((ext_vector_type(16)));
typedef short s16x4 __attribute__((ext_vector_type(4)));
typedef unsigned u32x2 __attribute__((ext_vector_type(2)));
typedef float f32x2v __attribute__((ext_vector_type(2)));

constexpr int S_ = 2048, DM = 1024, CTXL = 256, SALL = S_ + CTXL;
constexpr int MTOK = 8 * S_, MCTX = 8 * CTXL, MALL = MTOK + MCTX;
constexpr int INW = 4096, NIN = 4608, DFF = 2816, NGU = 5632;
constexpr float EPS = 1e-6f;
constexpr float LOG2E = 1.4426950408889634f;
constexpr float C2 = 0.125f * LOG2E;
constexpr int NTHREADS = 512;
constexpr int LDS_BYTES = 131072 + 64;

constexpr size_t MiB = 1u << 20;
constexpr size_t WS_MOD = 1 * MiB;
constexpr size_t WS_ROPE = WS_MOD + 256 * 1024;
constexpr size_t WS_BIAS2 = WS_ROPE + 512 * 1024;
constexpr size_t WS_SS1 = 2 * MiB;
constexpr size_t WS_SS2 = 3 * MiB;
constexpr size_t WS_PART = 4 * MiB;
constexpr size_t WS_WIN = 11 * MiB;
constexpr size_t WS_WAP = 20 * MiB;
constexpr size_t WS_WFP = 240 * MiB;
constexpr size_t WS_WO = 23 * MiB;
constexpr size_t WS_WGU = 25 * MiB;
constexpr size_t WS_WDN = 36 * MiB;
constexpr size_t WS_D = 42 * MiB;
constexpr size_t WS_H = 58 * MiB;
constexpr size_t WS_Y = WS_H;
constexpr size_t WS_Q = 94 * MiB;
constexpr size_t WS_K = 126 * MiB;
constexpr size_t WS_VT = 135 * MiB;
constexpr size_t WS_UVT = 144 * MiB;
constexpr size_t WS_MG = WS_UVT;
constexpr size_t WS_G = 176 * MiB;
constexpr size_t WS_A2 = WS_G;
constexpr size_t WS_ACT = 58 * MiB;
constexpr size_t WS_END = 242 * MiB;

struct Params { const float* in[18]; float* out; unsigned char* ws; };

__device__ __forceinline__ float wave_sum(float v) {
#pragma unroll
    for (int o = 1; o < 64; o <<= 1) v += __shfl_xor(v, o);
    return v;
}
__device__ __forceinline__ float sigmoid_(float v) { return __builtin_amdgcn_rcpf(1.f + __builtin_amdgcn_exp2f(-LOG2E * v)); }
__device__ __forceinline__ float bf_lo(unsigned w) { return __uint_as_float(w << 16); }
__device__ __forceinline__ float bf_hi(unsigned w) { return __uint_as_float(w & 0xffff0000u); }
__device__ __forceinline__ u32x4 pack8(const f32x4 a, const f32x4 b) { u32x4 w; w.x = cvt_pk_bf16(a[0], a[1]); w.y = cvt_pk_bf16(a[2], a[3]); w.z = cvt_pk_bf16(b[0], b[1]); w.w = cvt_pk_bf16(b[2], b[3]); return w; }
__device__ __forceinline__ unsigned short bf1(float v) { return (unsigned short)(cvt_pk_bf16(v, v) & 0xffffu); }

struct EpiIn {
    static constexpr bool PERM = true, AFTER_DRAIN = false;
    bf16_t *Q, *K, *VT, *UVT, *G; const float *gq, *gk, *bgate; const f32x2v* rope;
    __device__ __forceinline__ void operator()(const f32x4 (&acc)[2][2][4][2], const Unit& u, int wr, int wc, int fr, int fq) const {
        const int pn = u.pn; const bool isctx = u.pm >= 64;
        if (pn < 5) {
            const bool isq = pn < 4; const float* g = isq ? gq : gk; const float osc = isq ? C2 : 1.f;
            f32x4 gv[2][2];
#pragma unroll
            for (int bj = 0; bj < 2; ++bj)
#pragma unroll
                for (int n = 0; n < 2; ++n) gv[bj][n] = *(const f32x4*)(g + 32 * bj + 8 * fq + 4 * n);
#pragma unroll
            for (int ai = 0; ai < 2; ++ai)
#pragma unroll
                for (int m = 0; m < 4; ++m) {
                    const int r = u.pm * 256 + ai * 128 + wr * 64 + m * 16 + fr;
                    f32x4 v[2][2]; float ss = 0.f;
#pragma unroll
                    for (int bj = 0; bj < 2; ++bj)
#pragma unroll
                        for (int n = 0; n < 2; ++n) { v[bj][n] = acc[ai][bj][m][n]; const f32x4 t = v[bj][n]; ss += (t[0] * t[0] + t[1] * t[1]) + (t[2] * t[2] + t[3] * t[3]); }
                    ss += __shfl_xor(ss, 16); ss += __shfl_xor(ss, 32);
                    const float rs = __builtin_amdgcn_rsqf(ss * (1.f / 64.f) + EPS);
#pragma unroll
                    for (int bj = 0; bj < 2; ++bj)
#pragma unroll
                        for (int n = 0; n < 2; ++n) v[bj][n] = v[bj][n] * rs * gv[bj][n];
                    f32x4 o1[2], o2[2];
                    bf16_t* base;
                    if (!isctx) {
                        const int s = r & 2047; const f32x2v* rp = rope + s * 32 + 8 * fq;
#pragma unroll
                        for (int n = 0; n < 2; ++n)
#pragma unroll
                            for (int j = 0; j < 4; ++j) { const f32x2v cs = rp[4 * n + j]; o1[n][j] = (v[0][n][j] * cs.x - v[1][n][j] * cs.y) * osc; o2[n][j] = (v[1][n][j] * cs.x + v[0][n][j] * cs.y) * osc; }
                        base = isq ? Q + (size_t)r * 1024 + 64 * (4 * pn + wc) : K + ((size_t)(r >> 11) * SALL + CTXL + s) * 256 + 64 * wc;
                    } else {
                        o1[0] = v[0][0]; o1[1] = v[0][1]; o2[0] = v[1][0]; o2[1] = v[1][1];
                        const int rc = r - MTOK; base = K + ((size_t)(rc >> 8) * SALL + (rc & 255)) * 256 + 64 * wc;
                    }
                    *(u32x4*)(base + 8 * fq) = pack8(o1[0], o1[1]);
                    *(u32x4*)(base + 32 + 8 * fq) = pack8(o2[0], o2[1]);
                }
        } else if (pn == 5) {
#pragma unroll
            for (int ai = 0; ai < 2; ++ai)
#pragma unroll
                for (int m = 0; m < 4; ++m) {
                    const int r = u.pm * 256 + ai * 128 + wr * 64 + m * 16 + fr;
                    int b, pos; if (!isctx) { b = r >> 11; pos = CTXL + (r & 2047); } else { const int rc = r - MTOK; b = rc >> 8; pos = rc & 255; }
#pragma unroll
                    for (int bj = 0; bj < 2; ++bj) {
                        const int c0 = 128 * bj + 32 * wc + 8 * fq; const int kvh = c0 >> 6, d0 = c0 & 63;
                        bf16_t* vp = VT + ((size_t)(b * 4 + kvh) * 64 + d0) * SALL + pos;
#pragma unroll
                        for (int n = 0; n < 2; ++n)
#pragma unroll
                            for (int j = 0; j < 4; ++j) vp[(size_t)(4 * n + j) * SALL] = bf1(acc[ai][bj][m][n][j]);
                    }
                }
        } else if (pn < 10) {
            const int half = (pn - 6) >> 1; const int chb = 256 * ((pn - 6) & 1);
#pragma unroll
            for (int ai = 0; ai < 2; ++ai)
#pragma unroll
                for (int m = 0; m < 4; ++m) {
                    const int r = u.pm * 256 + ai * 128 + wr * 64 + m * 16 + fr;
                    const int b = r >> 11, s = r & 2047;
#pragma unroll
                    for (int bj = 0; bj < 2; ++bj) {
                        const int ch0 = chb + 128 * bj + 32 * wc + 8 * fq;
                        bf16_t* up = UVT + ((size_t)((half * 8 + b) * 512 + ch0)) * 2048 + s;
#pragma unroll
                        for (int n = 0; n < 2; ++n)
#pragma unroll
                            for (int j = 0; j < 4; ++j) up[(size_t)(4 * n + j) * 2048] = bf1(acc[ai][bj][m][n][j]);
                    }
                }
        } else {
            const int col0 = 256 * (pn - 10) + 32 * wc + 8 * fq;
            f32x4 bv[2][2];
#pragma unroll
            for (int bj = 0; bj < 2; ++bj)
#pragma unroll
                for (int n = 0; n < 2; ++n) bv[bj][n] = *(const f32x4*)(bgate + col0 + 128 * bj + 4 * n);
#pragma unroll
            for (int ai = 0; ai < 2; ++ai)
#pragma unroll
                for (int m = 0; m < 4; ++m) {
                    const int r = u.pm * 256 + ai * 128 + wr * 64 + m * 16 + fr;
#pragma unroll
                    for (int bj = 0; bj < 2; ++bj) {
                        f32x4 a = acc[ai][bj][m][0] + bv[bj][0], c = acc[ai][bj][m][1] + bv[bj][1];
#pragma unroll
                        for (int j = 0; j < 4; ++j) { a[j] = sigmoid_(a[j]); c[j] = sigmoid_(c[j]); }
                        *(u32x4*)(G + (size_t)r * 2048 + col0 + 128 * bj) = pack8(a, c);
                    }
                }
        }
    }
};

struct EpiY {
    static constexpr bool PERM = true, AFTER_DRAIN = false;
    bf16_t* Y;
    __device__ __forceinline__ void operator()(const f32x4 (&acc)[2][2][4][2], const Unit& u, int wr, int wc, int fr, int fq) const {
        const int kh = u.pn >> 4, pn = u.pn & 15, pm = u.pm & 7;
        const int b = pn >> 1; const int col0 = 512 * kh + 256 * (pn & 1) + 32 * wc + 8 * fq;
#pragma unroll
        for (int ai = 0; ai < 2; ++ai)
#pragma unroll
            for (int m = 0; m < 4; ++m) {
                const int row = b * 2048 + pm * 256 + ai * 128 + wr * 64 + m * 16 + fr;
#pragma unroll
                for (int bj = 0; bj < 2; ++bj) *(u32x4*)(Y + (size_t)row * 1024 + col0 + 128 * bj) = pack8(acc[ai][bj][m][0], acc[ai][bj][m][1]);
            }
    }
};

struct EpiGateF {
    static constexpr bool PERM = true, AFTER_DRAIN = false;
    const bf16_t* G; bf16_t* MG;
    __device__ __forceinline__ void operator()(const f32x4 (&acc)[2][2][4][2], const Unit& u, int wr, int wc, int fr, int fq) const {
        const int col0 = 256 * u.pn + 32 * wc + 8 * fq;
#pragma unroll
        for (int ai = 0; ai < 2; ++ai)
#pragma unroll
            for (int m = 0; m < 4; ++m) {
                const int r = u.pm * 256 + ai * 128 + wr * 64 + m * 16 + fr;
#pragma unroll
                for (int bj = 0; bj < 2; ++bj) {
                    const int col = col0 + 128 * bj;
                    const u32x4 gw = *(const u32x4*)(G + (size_t)r * 2048 + 1024 + col);
                    const f32x4 g0 = {bf_lo(gw.x), bf_hi(gw.x), bf_lo(gw.y), bf_hi(gw.y)}, g1 = {bf_lo(gw.z), bf_hi(gw.z), bf_lo(gw.w), bf_hi(gw.w)};
                    *(u32x4*)(MG + (size_t)r * 1024 + col) = pack8(acc[ai][bj][m][0] * g0, acc[ai][bj][m][1] * g1);
                }
            }
    }
};
struct EpiGateA {
    static constexpr bool PERM = true, AFTER_DRAIN = false;
    const bf16_t* G; bf16_t* MG;
    __device__ __forceinline__ void operator()(const f32x4 (&acc)[2][2][4][2], const Unit& u, int wr, int wc, int fr, int fq) const {
        const int col0 = 256 * u.pn + 32 * wc + 8 * fq;
#pragma unroll
        for (int ai = 0; ai < 2; ++ai)
#pragma unroll
            for (int m = 0; m < 4; ++m) {
                const int r = u.pm * 256 + ai * 128 + wr * 64 + m * 16 + fr;
#pragma unroll
                for (int bj = 0; bj < 2; ++bj) {
                    const int col = col0 + 128 * bj;
                    const u32x4 gw = *(const u32x4*)(G + (size_t)r * 2048 + col);
                    const u32x4 tw = *(const u32x4*)(MG + (size_t)r * 1024 + col);
                    const f32x4 g0 = {bf_lo(gw.x), bf_hi(gw.x), bf_lo(gw.y), bf_hi(gw.y)}, g1 = {bf_lo(gw.z), bf_hi(gw.z), bf_lo(gw.w), bf_hi(gw.w)};
                    const f32x4 t0 = {bf_lo(tw.x), bf_hi(tw.x), bf_lo(tw.y), bf_hi(tw.y)}, t1 = {bf_lo(tw.z), bf_hi(tw.z), bf_lo(tw.w), bf_hi(tw.w)};
                    *(u32x4*)(MG + (size_t)r * 1024 + col) = pack8(t0 + acc[ai][bj][m][0] * g0, t1 + acc[ai][bj][m][1] * g1);
                }
            }
    }
};


constexpr int O_TILE_OFF = (int)((WS_Q - WS_Y) / (256 * 1024 * 2));
constexpr int WFP_TILE_OFF = (int)((WS_WFP - WS_WAP) / (256 * 1024 * 2));
static_assert((WS_Q - WS_Y) % (256 * 1024 * 2) == 0 && (WS_WFP - WS_WAP) % (256 * 1024 * 2) == 0, "tile-aligned buffer offsets");
struct EpiMerge {
    static constexpr bool PERM = true, AFTER_DRAIN = false;
    EpiGateF F; EpiGateA A;
    __device__ __forceinline__ void operator()(const f32x4 (&acc)[2][2][4][2], const Unit& u, int wr, int wc, int fr, int fq) const {
        if (u.pn >= WFP_TILE_OFF) { const Unit v{u.pm, u.pn - WFP_TILE_OFF}; F(acc, v, wr, wc, fr, fq); }
        else { const Unit v{u.pm - O_TILE_OFF, u.pn}; A(acc, v, wr, wc, fr, fq); }
    }
};
struct SchedMerge {
    pg8::StaticOrder so;
    __device__ bool next(int i, Unit& u) const { if (!so.next(i >> 1, u)) return false; if (i & 1) u.pm += O_TILE_OFF; else u.pn += WFP_TILE_OFF; return true; }
    __device__ __forceinline__ void a_ready(const Unit&) const {}
    __device__ __forceinline__ void done(const Unit&) const {}
};

struct EpiWo {
    static constexpr bool PERM = true, AFTER_DRAIN = false;
    const float *x, *mod, *gnf; float* X1; bf16_t* A2; float* SS;
    __device__ __forceinline__ void operator()(const f32x4 (&acc)[2][2][4][2], const Unit& u, int wr, int wc, int fr, int fq) const {
        const int b = u.pm >> 3; const int col0 = 256 * u.pn + 32 * wc + 8 * fq;
        f32x4 gt[2][2], gm[2][2];
#pragma unroll
        for (int bj = 0; bj < 2; ++bj)
#pragma unroll
            for (int n = 0; n < 2; ++n) { const int col = col0 + 128 * bj + 4 * n;
                gt[bj][n] = *(const f32x4*)(mod + b * 6144 + 2 * 1024 + col);
                gm[bj][n] = *(const f32x4*)(gnf + col) * (*(const f32x4*)(mod + b * 6144 + 4 * 1024 + col) + 1.f); }
#pragma unroll
        for (int ai = 0; ai < 2; ++ai)
#pragma unroll
            for (int m = 0; m < 4; ++m) {
                const int r = u.pm * 256 + ai * 128 + wr * 64 + m * 16 + fr; float ss = 0.f;
#pragma unroll
                for (int bj = 0; bj < 2; ++bj) {
                    const size_t off = (size_t)r * 1024 + col0 + 128 * bj;
                    const f32x4 x0 = *(const f32x4*)(x + off) + gt[bj][0] * acc[ai][bj][m][0], x1 = *(const f32x4*)(x + off + 4) + gt[bj][1] * acc[ai][bj][m][1];
                    ss += (x0[0] * x0[0] + x0[1] * x0[1]) + (x0[2] * x0[2] + x0[3] * x0[3]) + (x1[0] * x1[0] + x1[1] * x1[1]) + (x1[2] * x1[2] + x1[3] * x1[3]);
                    *(f32x4*)(X1 + off) = x0; *(f32x4*)(X1 + off + 4) = x1;
                    *(u32x4*)(A2 + off) = pack8(x0 * gm[bj][0], x1 * gm[bj][1]);
                }
                ss += __shfl_xor(ss, 16); ss += __shfl_xor(ss, 32);
                if (fq == 0) SS[(size_t)r * 16 + 4 * u.pn + wc] = ss;
            }
    }
};

struct EpiGU {
    static constexpr bool PERM = true, AFTER_DRAIN = false;
    const float *SS, *bias2; bf16_t* ACT;
    __device__ __forceinline__ void operator()(const f32x4 (&acc)[2][2][4][2], const Unit& u, int wr, int wc, int fr, int fq) const {
        const int b = u.pm >> 3; const int c0 = 128 * u.pn + 32 * wc + 8 * fq;
        f32x4 bg[2], bu[2];
#pragma unroll
        for (int n = 0; n < 2; ++n) { bg[n] = *(const f32x4*)(bias2 + b * NGU + c0 + 4 * n); bu[n] = *(const f32x4*)(bias2 + b * NGU + DFF + c0 + 4 * n); }
#pragma unroll
        for (int ai = 0; ai < 2; ++ai)
#pragma unroll
            for (int m = 0; m < 4; ++m) {
                const int r = u.pm * 256 + ai * 128 + wr * 64 + m * 16 + fr;
                const f32x4* sp = (const f32x4*)(SS + (size_t)r * 16);
                const f32x4 s4 = (sp[0] + sp[1]) + (sp[2] + sp[3]);
                const float rs = __builtin_amdgcn_rsqf(((s4[0] + s4[1]) + (s4[2] + s4[3])) * (1.f / 1024.f) + EPS);
                f32x4 o[2];
#pragma unroll
                for (int n = 0; n < 2; ++n) { const f32x4 g = acc[ai][0][m][n] * rs + bg[n], up = acc[ai][1][m][n] * rs + bu[n];
#pragma unroll
                    for (int j = 0; j < 4; ++j) o[n][j] = g[j] * sigmoid_(g[j]) * up[j]; }
                *(u32x4*)(ACT + (size_t)r * DFF + c0) = pack8(o[0], o[1]);
            }
    }
};

struct EpiDown {
    static constexpr bool PERM = true, AFTER_DRAIN = false;
    const float* mod; float* X; float* SS;
    __device__ __forceinline__ void operator()(const f32x4 (&acc)[2][2][4][2], const Unit& u, int wr, int wc, int fr, int fq) const {
        const int b = u.pm >> 3; const int col0 = 256 * u.pn + 32 * wc + 8 * fq;
        f32x4 gt[2][2];
#pragma unroll
        for (int bj = 0; bj < 2; ++bj)
#pragma unroll
            for (int n = 0; n < 2; ++n) gt[bj][n] = *(const f32x4*)(mod + b * 6144 + 5 * 1024 + col0 + 128 * bj + 4 * n);
#pragma unroll
        for (int ai = 0; ai < 2; ++ai)
#pragma unroll
            for (int m = 0; m < 4; ++m) {
                const int r = u.pm * 256 + ai * 128 + wr * 64 + m * 16 + fr; float ss = 0.f;
#pragma unroll
                for (int bj = 0; bj < 2; ++bj) {
                    const size_t off = (size_t)r * 1024 + col0 + 128 * bj;
                    const f32x4 x0 = *(const f32x4*)(X + off) + gt[bj][0] * acc[ai][bj][m][0], x1 = *(const f32x4*)(X + off + 4) + gt[bj][1] * acc[ai][bj][m][1];
                    ss += (x0[0] * x0[0] + x0[1] * x0[1]) + (x0[2] * x0[2] + x0[3] * x0[3]) + (x1[0] * x1[0] + x1[1] * x1[1]) + (x1[2] * x1[2] + x1[3] * x1[3]);
                    *(f32x4*)(X + off) = x0; *(f32x4*)(X + off + 4) = x1;
                }
                ss += __shfl_xor(ss, 16); ss += __shfl_xor(ss, 32);
                if (fq == 0) SS[(size_t)r * 16 + 4 * u.pn + wc] = ss;
            }
    }
};


struct EpiDownFused {
    static constexpr bool PERM = true, AFTER_DRAIN = true;
    const float* mod; float* X; float* SS; unsigned* cnt; const float* gfin;
    __device__ __forceinline__ void fused(f32x4 (&acc)[2][2][4][2], const Unit& u, int wr, int wc, int fr, int fq, LAS unsigned char* lds, int wid, int lane) const {
        const int b = u.pm >> 3; const int col0 = 256 * u.pn + 32 * wc + 8 * fq;
        {
            f32x4 gt[2][2];
#pragma unroll
            for (int bj = 0; bj < 2; ++bj)
#pragma unroll
                for (int n = 0; n < 2; ++n) gt[bj][n] = *(const f32x4*)(mod + b * 6144 + 5 * 1024 + col0 + 128 * bj + 4 * n);
#pragma unroll
            for (int ai = 0; ai < 2; ++ai)
#pragma unroll
                for (int m = 0; m < 4; ++m) {
                    const int r = u.pm * 256 + ai * 128 + wr * 64 + m * 16 + fr; float ss = 0.f;
#pragma unroll
                    for (int bj = 0; bj < 2; ++bj) {
                        const size_t off = (size_t)r * 1024 + col0 + 128 * bj;
                        const f32x4 x0 = *(const f32x4*)(X + off) + gt[bj][0] * acc[ai][bj][m][0], x1 = *(const f32x4*)(X + off + 4) + gt[bj][1] * acc[ai][bj][m][1];
                        ss += (x0[0] * x0[0] + x0[1] * x0[1]) + (x0[2] * x0[2] + x0[3] * x0[3]) + (x1[0] * x1[0] + x1[1] * x1[1]) + (x1[2] * x1[2] + x1[3] * x1[3]);
                        acc[ai][bj][m][0] = x0; acc[ai][bj][m][1] = x1;
                    }
                    ss += __shfl_xor(ss, 16); ss += __shfl_xor(ss, 32);
                    if (fq == 0) __hip_atomic_store(SS + (size_t)r * 16 + 4 * u.pn + wc, ss, __ATOMIC_RELAXED, __HIP_MEMORY_SCOPE_AGENT);
                }
        }
        asm volatile("s_waitcnt vmcnt(0)" ::: "memory");
        unsigned* cw = cnt + 64 * u.pm;
        if (lane == 0) __hip_atomic_fetch_add(cw, 1u, __ATOMIC_RELAXED, __HIP_MEMORY_SCOPE_AGENT);
        if (wid == 0) {
            unsigned sp = 0;
            while ((unsigned)__builtin_amdgcn_readfirstlane(__hip_atomic_load(cw, __ATOMIC_RELAXED, __HIP_MEMORY_SCOPE_AGENT)) < 32u) { __builtin_amdgcn_s_sleep(2); if (++sp > (1u << 22)) break; }
            __builtin_amdgcn_fence(__ATOMIC_ACQUIRE, "agent");
        }
        asm volatile("s_waitcnt vmcnt(0) lgkmcnt(0)" ::: "memory"); __builtin_amdgcn_s_barrier(); asm volatile("" ::: "memory");
        LAS float* rsl = (LAS float*)lds;
        { const int t = wid * 64 + lane;
          if (t < 256) { const float* sp = SS + (size_t)(u.pm * 256 + t) * 16; float s = 0.f;
#pragma unroll
              for (int q = 0; q < 16; ++q) s += __hip_atomic_load(sp + q, __ATOMIC_RELAXED, __HIP_MEMORY_SCOPE_AGENT);
              rsl[t] = __builtin_amdgcn_rsqf(s * (1.f / 1024.f) + EPS); } }
        asm volatile("s_waitcnt vmcnt(0) lgkmcnt(0)" ::: "memory"); __builtin_amdgcn_s_barrier(); asm volatile("" ::: "memory");
        f32x4 gf[2][2];
#pragma unroll
        for (int bj = 0; bj < 2; ++bj)
#pragma unroll
            for (int n = 0; n < 2; ++n) gf[bj][n] = *(const f32x4*)(gfin + col0 + 128 * bj + 4 * n);
#pragma unroll
        for (int ai = 0; ai < 2; ++ai)
#pragma unroll
            for (int m = 0; m < 4; ++m) {
                const int rl = ai * 128 + wr * 64 + m * 16 + fr; const float rs = rsl[rl];
#pragma unroll
                for (int bj = 0; bj < 2; ++bj) {
                    const size_t off = (size_t)(u.pm * 256 + rl) * 1024 + col0 + 128 * bj;
                    *(f32x4*)(X + off) = acc[ai][bj][m][0] * rs * gf[bj][0]; *(f32x4*)(X + off + 4) = acc[ai][bj][m][1] * rs * gf[bj][1];
                }
            }
    }
};

struct EpiNull {
    static constexpr bool PERM = true, AFTER_DRAIN = false;
    float* sink;
    __device__ __forceinline__ void operator()(const f32x4 (&acc)[2][2][4][2], const Unit& u, int wr, int wc, int fr, int fq) const {
        if (acc[0][0][0][0][0] == 123456.789f) sink[0] = 1.f;
    }
};
struct SchedIn {
    pg8::StaticOrder so;
    __device__ void init(int G, int c) { so.init(MTOK, NIN, G, c); }
    __device__ bool next(int i, Unit& u) const {
        const long L = (long)i * so.G + so.c; if (L < so.nwg) return so.next(i, u);
        const int xx = (int)(L - so.nwg); if (xx >= 16) return false; u.pm = 64 + (xx >> 1); u.pn = 4 + (xx & 1); return true; }
    __device__ __forceinline__ void a_ready(const Unit&) const {}
    __device__ __forceinline__ void done(const Unit&) const {}
};
struct SchedFour {
    int G, c;
    __device__ bool next(int i, Unit& u) const { const long L = (long)i * G + c; if (L >= 256) return false; const int x = (int)L & 7, j = (int)L >> 3; const int kh = x >> 2;
        u.pm = kh * 8 + (j & 7); u.pn = kh * 16 + 4 * (x & 3) + (j >> 3); return true; }
    __device__ __forceinline__ void a_ready(const Unit&) const {}
    __device__ __forceinline__ void done(const Unit&) const {}
};

constexpr int KPITCH = 144, VPITCH = 136, KBUF = 64 * KPITCH, VBUF = 64 * VPITCH;
__device__ __forceinline__ void attn_qk(f32x16& sA, f32x16& sB, const LAS unsigned char* kb, const bf16x8 (&qr)[4], const f32x16& negm) {
#pragma unroll
    for (int ks = 0; ks < 4; ++ks) {
        const bf16x8 a0 = *(const LAS bf16x8*)(kb + ks * 32), a1 = *(const LAS bf16x8*)(kb + 32 * KPITCH + ks * 32);
        if (ks == 0) { sA = __builtin_amdgcn_mfma_f32_32x32x16_bf16(a0, qr[0], negm, 0, 0, 0); sB = __builtin_amdgcn_mfma_f32_32x32x16_bf16(a1, qr[0], negm, 0, 0, 0); }
        else { sA = __builtin_amdgcn_mfma_f32_32x32x16_bf16(a0, qr[ks], sA, 0, 0, 0); sB = __builtin_amdgcn_mfma_f32_32x32x16_bf16(a1, qr[ks], sB, 0, 0, 0); }
    }
}
constexpr float ATT_THR = 6.f;
__device__ __forceinline__ void attn_unit(LAS unsigned char* lds, const bf16_t* Q, const bf16_t* K, const bf16_t* VT, bf16_t* O, int b, int kvh, int qblk) {
    int tid_ = threadIdx.x; asm volatile("" : "+v"(tid_));
    const int tid = tid_, lane = tid & 63, r32 = lane & 31, hi = lane >> 5; const int wid = __builtin_amdgcn_readfirstlane(tid >> 6);
    const int h = 4 * kvh + (wid >> 1); const int s0 = 64 * qblk + 32 * (wid & 1);
    const size_t qoff = (size_t)(b * S_ + s0 + r32) * 1024 + h * 64;
    bf16x8 qr[4];
#pragma unroll
    for (int ks = 0; ks < 4; ++ks) qr[ks] = *(const bf16x8*)(Q + qoff + 16 * ks + 8 * hi);
    const int lrow = tid >> 3, lch = tid & 7;
    const bf16_t* kg = K + ((size_t)b * SALL + lrow) * 256 + kvh * 64 + lch * 8;
    const bf16_t* vg = VT + ((size_t)(b * 4 + kvh) * 64 + lrow) * SALL + lch * 8;
    LAS unsigned char* kw = lds + lrow * KPITCH + lch * 16;
    LAS unsigned char* vw = lds + 2 * KBUF + lrow * VPITCH + lch * 16;
    u32x4 kreg = *(const u32x4*)kg, vreg = *(const u32x4*)vg, kreg1 = *(const u32x4*)(kg + (size_t)64 * 256);
    __syncthreads();
    *(LAS u32x4*)kw = kreg; *(LAS u32x4*)(kw + KBUF) = kreg1; *(LAS u32x2*)vw = (u32x2){vreg.x, vreg.y}; *(LAS u32x2*)(vw + 8) = (u32x2){vreg.z, vreg.w};
    __syncthreads();
    float l = 0.f; f32x16 o0, o1, negm;
#pragma unroll
    for (int r = 0; r < 16; ++r) { o0[r] = 0.f; o1[r] = 0.f; negm[r] = 0.f; }
    const LAS unsigned char* kr = lds + r32 * KPITCH + hi * 16;
    const LAS unsigned char* vr = lds + 2 * KBUF + r32 * VPITCH + hi * 8;
    constexpr int NT = SALL / 64;
    f32x16 sA, sB, nA, nB;
    attn_qk(sA, sB, kr, qr, negm);
    __syncthreads();
#define ATT_STEP(CA, CB, NA, NB, T) do { \
        const int t_ = (T); const int cur = t_ & 1; \
        if (t_ + 2 < NT) kreg = *(const u32x4*)(kg + (size_t)(t_ + 2) * 64 * 256); \
        if (t_ + 1 < NT) vreg = *(const u32x4*)(vg + (t_ + 1) * 64); \
        if (t_ + 1 < NT) attn_qk(NA, NB, kr + (cur ^ 1) * KBUF, qr, negm); \
        const LAS unsigned char* vb = vr + cur * VBUF; \
        float mx0 = fmaxf(fmaxf(CA[0], CB[0]), CA[1]), mx1 = fmaxf(fmaxf(CB[1], CA[2]), CB[2]); \
        _Pragma("unroll") for (int r = 3; r < 15; r += 2) { mx0 = fmaxf(fmaxf(mx0, CA[r]), CB[r]); mx1 = fmaxf(fmaxf(mx1, CA[r + 1]), CB[r + 1]); } \
        float mx = fmaxf(fmaxf(mx0, mx1), fmaxf(CA[15], CB[15])); \
        mx = fmaxf(mx, __shfl_xor(mx, 32)); \
        if (t_ == 0 || __any(mx > ATT_THR)) { \
            const float dl = (t_ == 0) ? mx : fmaxf(mx, 0.f); \
            const float alpha = __builtin_amdgcn_exp2f(-dl); \
            l *= alpha; \
            _Pragma("unroll") for (int r = 0; r < 16; ++r) { CA[r] -= dl; CB[r] -= dl; o0[r] *= alpha; o1[r] *= alpha; negm[r] -= dl; NA[r] -= dl; NB[r] -= dl; } \
        } \
        float ps0 = 0.f, ps1 = 0.f; \
        _Pragma("unroll") for (int r = 0; r < 16; ++r) { CA[r] = __builtin_amdgcn_exp2f(CA[r]); CB[r] = __builtin_amdgcn_exp2f(CB[r]); ps0 += CA[r]; ps1 += CB[r]; } \
        l += ps0 + ps1; \
        bf16x8 pb[4]; \
        { u32x4 w; \
          w.x = cvt_pk_bf16(CA[0], CA[1]); w.y = cvt_pk_bf16(CA[2], CA[3]); w.z = cvt_pk_bf16(CA[4], CA[5]); w.w = cvt_pk_bf16(CA[6], CA[7]); pb[0] = __builtin_bit_cast(bf16x8, w); \
          w.x = cvt_pk_bf16(CA[8], CA[9]); w.y = cvt_pk_bf16(CA[10], CA[11]); w.z = cvt_pk_bf16(CA[12], CA[13]); w.w = cvt_pk_bf16(CA[14], CA[15]); pb[1] = __builtin_bit_cast(bf16x8, w); \
          w.x = cvt_pk_bf16(CB[0], CB[1]); w.y = cvt_pk_bf16(CB[2], CB[3]); w.z = cvt_pk_bf16(CB[4], CB[5]); w.w = cvt_pk_bf16(CB[6], CB[7]); pb[2] = __builtin_bit_cast(bf16x8, w); \
          w.x = cvt_pk_bf16(CB[8], CB[9]); w.y = cvt_pk_bf16(CB[10], CB[11]); w.z = cvt_pk_bf16(CB[12], CB[13]); w.w = cvt_pk_bf16(CB[14], CB[15]); pb[3] = __builtin_bit_cast(bf16x8, w); } \
        _Pragma("unroll") for (int ks = 0; ks < 4; ++ks) { \
            const int kvb = (32 * (ks >> 1) + 16 * (ks & 1)) * 2; \
            const s16x4 lo0 = *(const LAS s16x4*)(vb + kvb), hi0 = *(const LAS s16x4*)(vb + kvb + 16); \
            const s16x4 lo1 = *(const LAS s16x4*)(vb + 32 * VPITCH + kvb), hi1 = *(const LAS s16x4*)(vb + 32 * VPITCH + kvb + 16); \
            const bf16x8 a0 = {lo0[0], lo0[1], lo0[2], lo0[3], hi0[0], hi0[1], hi0[2], hi0[3]}; \
            const bf16x8 a1 = {lo1[0], lo1[1], lo1[2], lo1[3], hi1[0], hi1[1], hi1[2], hi1[3]}; \
            o0 = __builtin_amdgcn_mfma_f32_32x32x16_bf16(a0, pb[ks], o0, 0, 0, 0); \
            o1 = __builtin_amdgcn_mfma_f32_32x32x16_bf16(a1, pb[ks], o1, 0, 0, 0); \
        } \
        if (t_ + 2 < NT) *(LAS u32x4*)(kw + cur * KBUF) = kreg; \
        if (t_ + 1 < NT) { const int nb = cur ^ 1; *(LAS u32x2*)(vw + nb * VBUF) = (u32x2){vreg.x, vreg.y}; *(LAS u32x2*)(vw + nb * VBUF + 8) = (u32x2){vreg.z, vreg.w}; } \
        __syncthreads(); \
    } while (0)
    static_assert(NT % 2 == 0, "two tile steps per loop trip");
    for (int t = 0; t < NT; t += 2) {
        ATT_STEP(sA, sB, nA, nB, t);
        ATT_STEP(nA, nB, sA, sB, t + 1);
    }
#undef ATT_STEP
    l += __shfl_xor(l, 32);
    const float inv = 1.f / l;
    bf16_t* op = O + qoff + 4 * hi;
#pragma unroll
    for (int g = 0; g < 4; ++g) {
        u32x2 w0, w1;
        w0.x = cvt_pk_bf16(o0[4 * g] * inv, o0[4 * g + 1] * inv); w0.y = cvt_pk_bf16(o0[4 * g + 2] * inv, o0[4 * g + 3] * inv);
        w1.x = cvt_pk_bf16(o1[4 * g] * inv, o1[4 * g + 1] * inv); w1.y = cvt_pk_bf16(o1[4 * g + 2] * inv, o1[4 * g + 3] * inv);
        *(u32x2*)(op + 8 * g) = w0; *(u32x2*)(op + 32 + 8 * g) = w1;
    }
}

__device__ __forceinline__ void transpose_item(const float* W, int K, int Nsrc, bf16_t* WT, int dst_row0, int src_col0, int k0, LAS float* scr, int lane, int dk = 0) {
    f32x4 tv[8];
#pragma unroll
    for (int i = 0; i < 8; ++i) tv[i] = *(const f32x4*)(W + (size_t)(k0 + 8 * i + (lane >> 3)) * Nsrc + src_col0 + 4 * (lane & 7));
#pragma unroll
    for (int i = 0; i < 8; ++i) { LAS float* d = scr + (8 * i + (lane >> 3)) * 33 + 4 * (lane & 7); d[0] = tv[i][0]; d[1] = tv[i][1]; d[2] = tv[i][2]; d[3] = tv[i][3]; }
    asm volatile("s_waitcnt lgkmcnt(0)" ::: "memory");
    const int c = lane & 7;
#pragma unroll
    for (int j = 0; j < 4; ++j) { const int n = (lane >> 3) + 8 * j; const LAS float* s = scr + (8 * c) * 33 + n;
        u32x4 o; o.x = cvt_pk_bf16(s[0 * 33], s[1 * 33]); o.y = cvt_pk_bf16(s[2 * 33], s[3 * 33]); o.z = cvt_pk_bf16(s[4 * 33], s[5 * 33]); o.w = cvt_pk_bf16(s[6 * 33], s[7 * 33]);
        *(u32x4*)(WT + (size_t)(dst_row0 + n) * K + dk + k0 + 8 * c) = o; }
    asm volatile("s_waitcnt lgkmcnt(0)" ::: "memory");
}

__device__ __forceinline__ void phase0(const Params& p, LAS unsigned char* lds) {
    const int tid = threadIdx.x, lane = tid & 63; const int wave = __builtin_amdgcn_readfirstlane(tid >> 6);
    const int G = gridDim.x; const int gw = blockIdx.x * 8 + wave, NGW = G * 8;
    unsigned char* ws = p.ws;
    LAS float* scr = (LAS float*)(lds + wave * 16384);
    LAS float* wbuf = (LAS float*)(lds + wave * 16384 + 8448);
    LAS f32x2v* tw = (LAS f32x2v*)(lds + wave * 16384 + 8448 + 4096);
    {
        const float* wada = p.in[4]; float* PART = (float*)(ws + WS_PART); int ndone = 0;
        for (int it = NGW - 1 - gw; it < 16 * 96; it += NGW) {
            const int kc = it / 96, nb = it % 96; const int n = nb * 64 + lane;
            float sv[9];
#pragma unroll
            for (int r = 0; r < 9; ++r) { const float* cp = r < 8 ? p.in[1] + r * 1024 : p.in[3]; const float v = cp[kc * 64 + lane]; sv[r] = v * sigmoid_(v); }
            float a[9];
#pragma unroll
            for (int r = 0; r < 9; ++r) a[r] = 0.f;
#pragma unroll
            for (int kk = 0; kk < 64; ++kk) { const float w = wada[(size_t)(kc * 64 + kk) * 6144 + n];
#pragma unroll
                for (int r = 0; r < 9; ++r) a[r] += __uint_as_float(__builtin_amdgcn_readlane(__float_as_uint(sv[r]), kk)) * w; }
#pragma unroll
            for (int r = 0; r < 9; ++r) __hip_atomic_store(PART + ((size_t)kc * 9 + r) * 6144 + n, a[r], __ATOMIC_RELAXED, __HIP_MEMORY_SCOPE_AGENT);
            ++ndone;
        }
        asm volatile("s_waitcnt vmcnt(0)" ::: "memory");
        if (lane == 0 && ndone) __hip_atomic_fetch_add((unsigned*)ws + 8192, (unsigned)ndone, __ATOMIC_RELAXED, __HIP_MEMORY_SCOPE_AGENT);
    }
    constexpr int I_IN = 16 * 112, I_AP = 16 * 32, I_FP = 2 * 8 * 32, I_O = 16 * 32, I_GU = 16 * 176;
    constexpr int NT_ITEMS = I_IN + I_AP + I_FP + I_O + I_GU;
    for (int it = gw; it < NT_ITEMS; it += NGW) {
        int r = it;
        if (r < I_IN) { const int kb = r / 112; int gi = r % 112; if (gi >= 48) gi += 32;
            const int pn = gi >> 3, sub = gi & 7, bj = sub >> 2, wc = sub & 3; int src;
            if (pn < 4) src = 64 * (4 * pn + wc) + 32 * bj; else if (pn == 4) src = 1024 + 64 * wc + 32 * bj; else if (pn == 5) src = 1280 + 32 * sub; else src = 2048 + 256 * (pn - 10) + 32 * sub;
            transpose_item(p.in[8], 1024, INW, (bf16_t*)(ws + WS_WIN), 32 * gi, src, 64 * kb, scr, lane); continue; }
        r -= I_IN;
        if (r < I_AP) { transpose_item(p.in[12], 1024, 1024, (bf16_t*)(ws + WS_WAP), 32 * (r % 32), 32 * (r % 32), 64 * (r / 32), scr, lane); continue; }
        r -= I_AP;
        if (r < I_FP) { const int hf = r >> 8, rr = r & 255; transpose_item(p.in[13], 1024, 1024, (bf16_t*)(ws + WS_WFP), 32 * (rr % 32), 32 * (rr % 32), 64 * (rr / 32), scr, lane, 512 * hf); continue; }
        r -= I_FP;
        if (r < I_O) { transpose_item(p.in[14], 1024, 1024, (bf16_t*)(ws + WS_WO), 32 * (r % 32), 32 * (r % 32), 64 * (r / 32), scr, lane); continue; }
        r -= I_O;
        { const int kb = r / 176, gi = r % 176; const int pn = gi >> 3, sub = gi & 7, bj = sub >> 2, q32 = sub & 3;
            transpose_item(p.in[15], 1024, NGU, (bf16_t*)(ws + WS_WGU), 32 * gi, (bj ? DFF : 0) + 128 * pn + 32 * q32, 64 * kb, scr, lane); }
    }
    {
        for (int i = lane; i < 128; i += 64) { const float rev = (float)i * (1.f / 128.f); tw[i] = (f32x2v){__builtin_amdgcn_cosf(rev), __builtin_amdgcn_sinf(rev)}; }
        const float* win = p.in[8]; bf16_t* WIN = (bf16_t*)(ws + WS_WIN);
        for (int it = gw; it < 2048; it += NGW) {
            const int g = it & 3, k0 = 4 * ((it >> 2) & 255), cp = lane + 64 * (it >> 10);
            asm volatile("s_waitcnt lgkmcnt(0)" ::: "memory");
#pragma unroll
            for (int i = 0; i < 8; ++i) { const int idx = i * 64 + lane, kk = idx >> 7, cc = idx & 127; wbuf[cc * 4 + kk] = win[(size_t)(k0 + kk) * INW + 1536 + 128 * g + cc]; }
            asm volatile("s_waitcnt lgkmcnt(0)" ::: "memory");
            float aU[4], aV[4];
#pragma unroll
            for (int kk = 0; kk < 4; ++kk) { aU[kk] = 0.f; aV[kk] = 0.f; }
#pragma unroll 4
            for (int cc = 0; cc < 128; ++cc) {
                const f32x4 w0 = *(const LAS f32x4*)(wbuf + cc * 4); const f32x2v cs = tw[(cc * cp) & 127];
#pragma unroll
                for (int kk = 0; kk < 4; ++kk) { aU[kk] += w0[kk] * cs.x; aV[kk] += w0[kk] * cs.y; }
            }
            const float sc = 0.08838834764831845f;
            u32x2 wu, wv;
            wu.x = cvt_pk_bf16(aU[0] * sc, aU[1] * sc); wu.y = cvt_pk_bf16(aU[2] * sc, aU[3] * sc);
            wv.x = cvt_pk_bf16(aV[0] * sc, aV[1] * sc); wv.y = cvt_pk_bf16(aV[2] * sc, aV[3] * sc);
            *(u32x2*)(WIN + (size_t)(1536 + 128 * g + cp) * 1024 + k0) = wu;
            *(u32x2*)(WIN + (size_t)(1536 + 512 + 128 * g + cp) * 1024 + k0) = wv;
        }
    }
    {
        f32x2v* R = (f32x2v*)(ws + WS_ROPE);
        for (int i = blockIdx.x * NTHREADS + tid; i < 2048 * 32; i += G * NTHREADS) {
            const int s = i >> 5, e = i & 31; const float pos = (float)(e < 16 ? (s >> 6) : (s & 63));
            const float invf = __builtin_amdgcn_exp2f(-(float)(e & 15) * (13.287712379549449f / 16.f));
            float rev = pos * invf * 0.15915494309189535f; rev -= floorf(rev);
            R[i] = (f32x2v){__builtin_amdgcn_cosf(rev), __builtin_amdgcn_sinf(rev)};
        }
    }
}

__device__ __forceinline__ void late_wdown(const Params& p, LAS unsigned char* lds, int first) {
    if ((int)blockIdx.x < first) return;
    const int tid = threadIdx.x, lane = tid & 63; const int wave = __builtin_amdgcn_readfirstlane(tid >> 6);
    const int gw = ((int)blockIdx.x - first) * 8 + wave, NGW = ((int)gridDim.x - first) * 8;
    LAS float* scr = (LAS float*)(lds + wave * 16384);
    for (int r = gw; r < 44 * 32; r += NGW) transpose_item(p.in[16], DFF, 1024, (bf16_t*)(p.ws + WS_WDN), 32 * (r % 32), 32 * (r % 32), 64 * (r / 32), scr, lane);
}
__device__ __forceinline__ void late_prologue(const Params& p, int first) {
    if ((int)blockIdx.x < first) return;
    const int tid = threadIdx.x; const int G = gridDim.x - first; const int bx = (int)blockIdx.x - first; unsigned char* ws = p.ws;
    {
        bf16_t* D = (bf16_t*)(ws + WS_D); const float sc = 0.022097086912079608f;
        for (int i = bx * NTHREADS + tid; i < 2 * 2048 * 256; i += G * NTHREADS) {
            const int kh = i >> 19, n = (i >> 8) & 2047, k8 = (i & 255) * 8; float v[8];
#pragma unroll
            for (int j = 0; j < 8; ++j) { const float rev = (float)((n * (k8 + j)) & 2047) * (1.f / 2048.f);
                v[j] = kh == 0 ? __builtin_amdgcn_cosf(rev) * sc : -__builtin_amdgcn_sinf(rev) * sc; }
            u32x4 w; w.x = cvt_pk_bf16(v[0], v[1]); w.y = cvt_pk_bf16(v[2], v[3]); w.z = cvt_pk_bf16(v[4], v[5]); w.w = cvt_pk_bf16(v[6], v[7]);
            *(u32x4*)(D + (size_t)i * 8) = w;
        }
    }
}

__device__ __forceinline__ void phase1(const Params& p, LAS unsigned char* lds) {
    const int tid = threadIdx.x, lane = tid & 63; const int wave = __builtin_amdgcn_readfirstlane(tid >> 6);
    const int G = gridDim.x; unsigned char* ws = p.ws;
    const float* PART = (const float*)(ws + WS_PART); const float* bada = p.in[5];
    float* MOD = (float*)(ws + WS_MOD);
    if (wave == 0) {
        unsigned sp = 0;
        while ((unsigned)__builtin_amdgcn_readfirstlane(__hip_atomic_load((unsigned*)ws + 8192, __ATOMIC_RELAXED, __HIP_MEMORY_SCOPE_AGENT)) < 16u * 96u) { __builtin_amdgcn_s_sleep(2); if (++sp > (1u << 22)) break; }
    }
    asm volatile("s_waitcnt vmcnt(0) lgkmcnt(0)" ::: "memory"); __syncthreads();
    for (int o = blockIdx.x * NTHREADS + tid; o < 9 * 6144; o += G * NTHREADS) {
        const int r = o / 6144, n = o % 6144; float a = bada[n];
#pragma unroll
        for (int kc = 0; kc < 16; ++kc) a += __hip_atomic_load(PART + ((size_t)kc * 9 + r) * 6144 + n, __ATOMIC_RELAXED, __HIP_MEMORY_SCOPE_AGENT);
        MOD[o] = a;
    }
    LAS float* tab = (LAS float*)lds;
    bf16_t* H = (bf16_t*)(ws + WS_H);
    for (int blk = blockIdx.x; blk < MALL / 72; blk += G) {
        const int r0 = blk * 72, r1 = r0 + 71;
        const int m0 = r0 < MTOK ? (r0 >> 11) : 8, m1 = r1 < MTOK ? (r1 >> 11) : 8;
        __syncthreads();
        for (int q = 0; q < (m1 != m0 ? 2 : 1); ++q) {
            const int mrow = q ? m1 : m0;
            for (int k = tid; k < 1024; k += NTHREADS) {
                float a_sh = bada[k], a_sc = bada[1024 + k];
#pragma unroll
                for (int kc = 0; kc < 16; ++kc) { a_sh += __hip_atomic_load(PART + ((size_t)kc * 9 + mrow) * 6144 + k, __ATOMIC_RELAXED, __HIP_MEMORY_SCOPE_AGENT); a_sc += __hip_atomic_load(PART + ((size_t)kc * 9 + mrow) * 6144 + 1024 + k, __ATOMIC_RELAXED, __HIP_MEMORY_SCOPE_AGENT); }
                tab[q * 2048 + k] = p.in[6][k] * (1.f + a_sc); tab[q * 2048 + 1024 + k] = a_sh;
            }
        }
        __syncthreads();
        f32x4 v[9][4];
#pragma unroll
        for (int rr = 0; rr < 9; ++rr) {
            const int row = r0 + wave * 9 + rr;
            const float* src = row < MTOK ? p.in[0] + (size_t)row * 1024 : p.in[2] + (size_t)(row - MTOK) * 1024;
#pragma unroll
            for (int j = 0; j < 4; ++j) v[rr][j] = __builtin_nontemporal_load((const f32x4*)(src + 4 * lane + 256 * j));
        }
#pragma unroll
        for (int rr = 0; rr < 9; ++rr) {
            const int row = r0 + wave * 9 + rr; const int mr = row < MTOK ? (row >> 11) : 8;
            LAS float* gm = tab + (mr != m0 ? 2048 : 0); LAS float* sh = gm + 1024;
            float s = 0.f;
#pragma unroll
            for (int j = 0; j < 4; ++j) s += (v[rr][j][0] * v[rr][j][0] + v[rr][j][1] * v[rr][j][1]) + (v[rr][j][2] * v[rr][j][2] + v[rr][j][3] * v[rr][j][3]);
            const float rs = __builtin_amdgcn_rsqf(wave_sum(s) * (1.f / 1024.f) + EPS);
#pragma unroll
            for (int j = 0; j < 4; ++j) { const int k = 4 * lane + 256 * j; const f32x4 g4 = *(const LAS f32x4*)(gm + k), s4 = *(const LAS f32x4*)(sh + k);
                const f32x4 o = v[rr][j] * rs * g4 + s4; u32x2 w; w.x = cvt_pk_bf16(o[0], o[1]); w.y = cvt_pk_bf16(o[2], o[3]);
                *(u32x2*)(H + (size_t)row * 1024 + k) = w; }
        }
    }
}

__device__ __forceinline__ void bias2_phase(const Params& p, LAS unsigned char* lds, int first) {
    const int tid = threadIdx.x, lane = tid & 63; const int wave = __builtin_amdgcn_readfirstlane(tid >> 6);
    const int G = gridDim.x; unsigned char* ws = p.ws;
    const float* MOD = (const float*)(ws + WS_MOD); const bf16_t* WGU = (const bf16_t*)(ws + WS_WGU); float* B2 = (float*)(ws + WS_BIAS2);
    f32x4 sh[4];
#pragma unroll
    for (int q = 0; q < 4; ++q) sh[q] = *(const f32x4*)(MOD + wave * 6144 + 3 * 1024 + 16 * lane + 4 * q);
    if ((int)blockIdx.x < first) return;
    const int nblk = G - first; const int rows_per = (NGU + nblk - 1) / nblk;
    const int rbeg = ((int)blockIdx.x - first) * rows_per, rend = (rbeg + rows_per < NGU) ? rbeg + rows_per : NGU;
    for (int r0 = rbeg; r0 < rend; r0 += 11) {
        u32x4 w0[11], w1[11];
#pragma unroll
        for (int r = 0; r < 11; ++r) { const int row = (r0 + r < rend) ? r0 + r : r0;
            w0[r] = *(const u32x4*)(WGU + (size_t)row * 1024 + 16 * lane); w1[r] = *(const u32x4*)(WGU + (size_t)row * 1024 + 16 * lane + 8); }
        float part[11];
#pragma unroll
        for (int r = 0; r < 11; ++r) {
            const f32x4 f0 = {bf_lo(w0[r].x), bf_hi(w0[r].x), bf_lo(w0[r].y), bf_hi(w0[r].y)}, f1 = {bf_lo(w0[r].z), bf_hi(w0[r].z), bf_lo(w0[r].w), bf_hi(w0[r].w)};
            const f32x4 f2 = {bf_lo(w1[r].x), bf_hi(w1[r].x), bf_lo(w1[r].y), bf_hi(w1[r].y)}, f3 = {bf_lo(w1[r].z), bf_hi(w1[r].z), bf_lo(w1[r].w), bf_hi(w1[r].w)};
            const f32x4 a4 = f0 * sh[0] + f1 * sh[1] + f2 * sh[2] + f3 * sh[3]; part[r] = (a4[0] + a4[1]) + (a4[2] + a4[3]);
        }
#pragma unroll
        for (int o = 1; o < 64; o <<= 1)
#pragma unroll
            for (int r = 0; r < 11; ++r) part[r] += __shfl_xor(part[r], o);
        if (lane == 0) {
#pragma unroll
            for (int r = 0; r < 11; ++r) { const int row = r0 + r;
                if (row < rend) { const int rem = row & 255; const int cidx = (rem < 128 ? 0 : DFF) + 128 * (row >> 8) + (rem & 127); B2[wave * NGU + cidx] = part[r]; } }
        }
    }
}

__device__ __forceinline__ void phase_final(const Params& p) {
    const int tid = threadIdx.x, lane = tid & 63; const int wave = __builtin_amdgcn_readfirstlane(tid >> 6);
    const int gw = blockIdx.x * 8 + wave, NGW = gridDim.x * 8;
    const float* SS = (const float*)(p.ws + WS_SS2); const float* gf = p.in[17]; float* out = p.out;
    f32x4 g4[4];
#pragma unroll
    for (int j = 0; j < 4; ++j) g4[j] = *(const f32x4*)(gf + 4 * lane + 256 * j);
    for (int row = gw; row < MTOK; row += NGW) {
        const f32x4* sp = (const f32x4*)(SS + (size_t)row * 16);
        const f32x4 s4 = (sp[0] + sp[1]) + (sp[2] + sp[3]);
        const float rs = __builtin_amdgcn_rsqf(((s4[0] + s4[1]) + (s4[2] + s4[3])) * (1.f / 1024.f) + EPS);
#pragma unroll
        for (int j = 0; j < 4; ++j) { f32x4* q = (f32x4*)(out + (size_t)row * 1024 + 4 * lane + 256 * j); *q = *q * rs * g4[j]; }
    }
}


#ifndef DBG_STOP
#define DBG_STOP 0
#endif
#ifndef REP_PH
#define REP_PH -1
#endif
#define NREP(k) ((REP_PH == (k)) ? 2 : 1)
__device__ __forceinline__ float bfv(const bf16_t* p, size_t i) { return __uint_as_float((unsigned)p[i] << 16); }
__device__ __forceinline__ void dbg_dump(const Params& p, int which) {
    unsigned char* ws = p.ws; const size_t N = (size_t)MTOK * 1024;
    for (size_t i = (size_t)blockIdx.x * NTHREADS + threadIdx.x; i < N; i += (size_t)gridDim.x * NTHREADS) {
        float v = 0.f;
        if (which == 2) v = bfv((const bf16_t*)(ws + WS_Q), i) + bfv((const bf16_t*)(ws + WS_G), 2 * i) + bfv((const bf16_t*)(ws + WS_G), 2 * i + 1) + bfv((const bf16_t*)(ws + WS_UVT), i)
                          + bfv((const bf16_t*)(ws + WS_K), i % 4718592) + bfv((const bf16_t*)(ws + WS_VT), i % 4718592);
        else if (which == 3) v = bfv((const bf16_t*)(ws + WS_Q), i) + bfv((const bf16_t*)(ws + WS_Y), i);
        else if (which == 4) v = bfv((const bf16_t*)(ws + WS_MG), i);
        else if (which == 5) v = p.out[i] + bfv((const bf16_t*)(ws + WS_A2), i);
        else if (which == 1) v = bfv((const bf16_t*)(ws + WS_H), i) + bfv((const bf16_t*)(ws + WS_WIN), i % 4718592) + bfv((const bf16_t*)(ws + WS_D), i % 8388608) + bfv((const bf16_t*)(ws + WS_WGU), i % 5767168);
        p.out[i] = v;
    }
}
#define DBG_AT(k) do { if (DBG_STOP == (k)) { dbg_dump(p, (k)); return; } } while (0)
#define XB_TMO      128
#define XB_XCNT(j)  (256  + 64 * (j))
#define XB_XSUB(j)  (1280 + 64 * (j))
#define XB_XGEN(j)  (2304 + 64 * (j))
#define XB_TOP      3328
#define XB_TOPGEN   3392
#define XCD_BAR_WORDS 3456
#define XB_SPIN_CAP (1u << 18)

__device__ __forceinline__ unsigned xb_ld(unsigned* p)              { return __hip_atomic_load(p, __ATOMIC_RELAXED, __HIP_MEMORY_SCOPE_AGENT); }
__device__ __forceinline__ unsigned xb_add(unsigned* p, unsigned v) { return __hip_atomic_fetch_add(p, v, __ATOMIC_RELAXED, __HIP_MEMORY_SCOPE_AGENT); }
__device__ __forceinline__ unsigned xb_xcc_id() { return (unsigned)__builtin_amdgcn_s_getreg((3 << 11) | 20) & 0xFu; }
#define XB_SPIN(cond, bar) do { unsigned _sp = 0; while (cond) { __builtin_amdgcn_s_sleep(1); \
    if ((++_sp & 255u) == 0u) { if (xb_ld(&(bar)[XB_TMO])) break; if (_sp > XB_SPIN_CAP) { atomicAdd(&(bar)[XB_TMO], 1u); break; } } } } while (0)

struct XcdBarrier {
    unsigned* bar; unsigned x;
    volatile LAS unsigned* st;
};

__device__ __forceinline__ XcdBarrier xcd_barrier_post(unsigned* bar, volatile LAS unsigned* st) {
    XcdBarrier b; b.bar = bar; b.x = xb_xcc_id(); b.st = st;
    if (threadIdx.x == 0) (void)xb_add(&bar[XB_XCNT(b.x)], 1u);
    return b;
}
__device__ __forceinline__ void xcd_barrier_complete(unsigned* bar, unsigned x, unsigned& nloc, unsigned& nx) {
    const unsigned G = gridDim.x * gridDim.y * gridDim.z;
    unsigned sum, cnt, mine, sp = 0u;
    for (;;) {
        sum = 0u; cnt = 0u; mine = 0u;
#pragma unroll
        for (unsigned j = 0; j < 16; ++j) { const unsigned c = xb_ld(&bar[XB_XCNT(j)]); sum += c; cnt += (c > 0u) ? 1u : 0u; mine = (j == x) ? c : mine; }
        if (sum == G) break;
        __builtin_amdgcn_s_sleep(1);
        if ((++sp & 255u) == 0u) { if (xb_ld(&bar[XB_TMO])) break; if (sp > XB_SPIN_CAP) { atomicAdd(&bar[XB_TMO], 1u); break; } }
    }
    nloc = mine > 0u ? mine : 1u; nx = cnt > 0u ? cnt : 1u;
}

__device__ __forceinline__ void xcd_barrier(const XcdBarrier& b) {
    asm volatile("s_waitcnt vmcnt(0)" ::: "memory");
    __syncthreads();
    if (threadIdx.x == 0) {
        unsigned* bar = b.bar;
        __builtin_amdgcn_s_waitcnt(0);
        unsigned nloc = b.st[0], nx = b.st[1];
        if (nloc == 0u) { xcd_barrier_complete(bar, b.x, nloc, nx); b.st[0] = nloc; b.st[1] = nx; }
        const unsigned old = xb_add(&bar[XB_XSUB(b.x)], 1u);
        const unsigned gen = old / nloc;
        if (old + 1u == (gen + 1u) * nloc) {
            __builtin_amdgcn_fence(__ATOMIC_RELEASE, "agent");
            asm volatile("s_waitcnt vmcnt(0)" ::: "memory");
            const unsigned og = xb_add(&bar[XB_TOP], 1u);
            const unsigned tg = og / nx;
            if (og + 1u == (tg + 1u) * nx) xb_add(&bar[XB_TOPGEN], 1u);
            else XB_SPIN(xb_ld(&bar[XB_TOPGEN]) == tg, bar);
            __builtin_amdgcn_fence(__ATOMIC_ACQUIRE, "agent");
            xb_add(&bar[XB_XGEN(b.x)], 1u);
            asm volatile("s_waitcnt vmcnt(0)" ::: "memory");
        } else {
            XB_SPIN(xb_ld(&bar[XB_XGEN(b.x)]) == gen, bar);
            __builtin_amdgcn_fence(__ATOMIC_ACQUIRE, "agent");
            asm volatile("s_waitcnt vmcnt(0)" ::: "memory");
        }
    }
    __syncthreads();
}

__global__ void __launch_bounds__(NTHREADS, 2) fwd_megakernel(Params p) {
    extern __shared__ __attribute__((aligned(16))) unsigned char lds_raw[];
    LAS unsigned char* lds = (LAS unsigned char*)lds_raw;
    cg::grid_group grid = cg::this_grid();
    if (gridDim.x == 0x7fffffffu) grid.sync();
    volatile LAS unsigned* bar_st = (volatile LAS unsigned*)(lds + 131072);
    if (threadIdx.x < 2) bar_st[threadIdx.x] = 0u;
    __syncthreads();
    const XcdBarrier xbar = xcd_barrier_post((unsigned*)p.ws, bar_st);
#define GRID_SYNC() xcd_barrier(xbar)
    unsigned char* ws = p.ws;
    const int G = gridDim.x, c = blockIdx.x;

    for (int rep = 0; rep < NREP(0); ++rep) { phase0(p, lds); __syncthreads(); }
    for (int rep = 0; rep < NREP(1); ++rep) { phase1(p, lds); __syncthreads(); }
    GRID_SYNC();
    DBG_AT(1);
    for (int rep = 0; rep < NREP(2); ++rep) {
        pg8::Gemm g{(const bf16_t*)(ws + WS_H), (const bf16_t*)(ws + WS_WIN), MALL, NIN, 1024};
        SchedIn Sd; Sd.init(G, c);
        EpiIn E{(bf16_t*)(ws + WS_Q), (bf16_t*)(ws + WS_K), (bf16_t*)(ws + WS_VT), (bf16_t*)(ws + WS_UVT), (bf16_t*)(ws + WS_G), p.in[10], p.in[11], p.in[9], (const f32x2v*)(ws + WS_ROPE)};
        pg8::gemm_phase<EpiIn, SchedIn, true, true>(lds, g, Sd, E);
        bias2_phase(p, lds, G == 256 ? 144 : 0);
        late_prologue(p, G == 256 ? 144 : 0);
    }
    GRID_SYNC();
    DBG_AT(2);
    {
        const bf16_t* Q = (const bf16_t*)(ws + WS_Q);
        for (int rep = 0; rep < NREP(3); ++rep) {
        bf16_t* Odst = (rep + 1 < NREP(3)) ? (bf16_t*)p.out : (bf16_t*)(ws + WS_Q);
        for (int i = 0;; ++i) {
            const long L = (long)i * G + c; if (L >= 1024) break;
            int pair, qblk;
            if (G == 256) { pair = (c & 7) * 4 + i; qblk = c >> 3; } else { pair = (int)(L >> 5); qblk = (int)(L & 31); }
            attn_unit(lds, Q, (const bf16_t*)(ws + WS_K), (const bf16_t*)(ws + WS_VT), Odst, pair >> 2, pair & 3, qblk);
        }
        __syncthreads();
        }
        pg8::Gemm g{(const bf16_t*)(ws + WS_D), (const bf16_t*)(ws + WS_UVT), 4096, 16384, 2048};
        SchedFour Sd{G, c};
        EpiY E{(bf16_t*)(ws + WS_Y)};
        for (int rep = 0; rep < NREP(9); ++rep) pg8::gemm_phase<EpiY, SchedFour, true, true>(lds, g, Sd, E);
    }
    GRID_SYNC();
    DBG_AT(3);
    for (int rep = 0; rep < NREP(4); ++rep) {
        pg8::StaticOrder Sd; Sd.init(MTOK, 1024, G, c);
        pg8::Gemm g{(const bf16_t*)(ws + WS_Y), (const bf16_t*)(ws + WS_WAP), MTOK, 1024, 1024};
        SchedMerge Sm{Sd};
        EpiMerge E{EpiGateF{(const bf16_t*)(ws + WS_G), (bf16_t*)(ws + WS_MG)}, EpiGateA{(const bf16_t*)(ws + WS_G), (bf16_t*)(ws + WS_MG)}};
        pg8::gemm_phase<EpiMerge, SchedMerge, true, true>(lds, g, Sm, E);
    }
    GRID_SYNC();
    DBG_AT(4);
    for (int rep = 0; rep < NREP(5); ++rep) {
        pg8::StaticOrder Sd; Sd.init(MTOK, 1024, G, c);
        pg8::Gemm g{(const bf16_t*)(ws + WS_MG), (const bf16_t*)(ws + WS_WO), MTOK, 1024, 1024};
        EpiWo E{p.in[0], (const float*)(ws + WS_MOD), p.in[7], p.out, (bf16_t*)(ws + WS_A2), (float*)(ws + WS_SS1)};
        pg8::gemm_phase<EpiWo, pg8::StaticOrder, true, true>(lds, g, Sd, E);
    }
    GRID_SYNC();
    DBG_AT(5);
    for (int rep = 0; rep < NREP(6); ++rep) {
        pg8::StaticOrder Sd; Sd.init(MTOK, NGU, G, c);
        pg8::Gemm g{(const bf16_t*)(ws + WS_A2), (const bf16_t*)(ws + WS_WGU), MTOK, NGU, 1024};
        EpiGU E{(const float*)(ws + WS_SS1), (const float*)(ws + WS_BIAS2), (bf16_t*)(ws + WS_ACT)};
        pg8::gemm_phase<EpiGU, pg8::StaticOrder, true, true>(lds, g, Sd, E);
        late_wdown(p, lds, G == 256 ? 128 : 0);
    }
    GRID_SYNC();
    if (G == 256) {
        pg8::StaticOrder Sd; Sd.init(MTOK, 1024, G, c);
        pg8::Gemm g{(const bf16_t*)(ws + WS_ACT), (const bf16_t*)(ws + WS_WDN), MTOK, 1024, DFF};
        EpiDownFused E{(const float*)(ws + WS_MOD), p.out, (float*)(ws + WS_SS2), (unsigned*)ws + 4096, p.in[17]};
        if (REP_PH == 7) { EpiNull E0{(float*)(ws + WS_SS2)}; pg8::gemm_phase<EpiNull, pg8::StaticOrder, true, true>(lds, g, Sd, E0); }
        pg8::gemm_phase<EpiDownFused, pg8::StaticOrder, false, true>(lds, g, Sd, E);
        return;
    }
    {
        pg8::StaticOrder Sd; Sd.init(MTOK, 1024, G, c);
        pg8::Gemm g{(const bf16_t*)(ws + WS_ACT), (const bf16_t*)(ws + WS_WDN), MTOK, 1024, DFF};
        EpiDown E{(const float*)(ws + WS_MOD), p.out, (float*)(ws + WS_SS2)};
        pg8::gemm_phase<EpiDown, pg8::StaticOrder, true, true>(lds, g, Sd, E);
    }
    GRID_SYNC();
    if (REP_PH == 8) { for (int rep = 0; rep < 8; ++rep) GRID_SYNC(); }
    phase_final(p);
}

extern "C" void kernel_launch(void* const* d_in, const int* in_sizes, int n_in, void* d_out, int out_size, void* d_ws, size_t ws_size, hipStream_t stream) {
    static int grid_blocks = 0;
    if (grid_blocks == 0) {
        if (n_in != 18 || out_size != MTOK * DM || ws_size < WS_END) { fprintf(stderr, "kernel_launch: unexpected shapes (n_in %d out %d ws %zu)\n", n_in, out_size, ws_size); grid_blocks = -1; return; }
        int dev = 0, cus = 0, per_cu = 0;
        hipGetDevice(&dev);
        hipDeviceGetAttribute(&cus, hipDeviceAttributeMultiprocessorCount, dev);
        hipFuncSetAttribute((const void*)fwd_megakernel, hipFuncAttributeMaxDynamicSharedMemorySize, LDS_BYTES);
        hipOccupancyMaxActiveBlocksPerMultiprocessor(&per_cu, (const void*)fwd_megakernel, NTHREADS, LDS_BYTES);
        if (per_cu < 1) { fprintf(stderr, "kernel_launch: occupancy query says %d blocks per CU\n", per_cu); per_cu = 1; }
        if (per_cu > 1) per_cu = 1;
        grid_blocks = cus * per_cu;
    }
    if (grid_blocks < 0) return;
    Params p{};
    for (int i = 0; i < 18; ++i) p.in[i] = (const float*)d_in[i];
    p.out = (float*)d_out; p.ws = (unsigned char*)d_ws;
    if (hipMemsetAsync(d_ws, 0, 65536, stream) != hipSuccess) { fprintf(stderr, "kernel_launch: memset of the barrier words failed\n"); return; }
    void* args[] = {&p};
    hipError_t e = hipLaunchCooperativeKernel((const void*)fwd_megakernel, dim3(grid_blocks), dim3(NTHREADS), args, LDS_BYTES, stream);
    if (e != hipSuccess) fprintf(stderr, "cooperative launch failed: %s (grid %d)\n", hipGetErrorString(e), grid_blocks);
}
```
